# Optimizing an MI355X kernel written in HIP

```python
import math
import jax, jax.numpy as jnp
from jax import lax
import numpy as np

D_MODEL = 1024
BATCH = 8
SEQ = 8192
DEPTH = 1

FOX_HEADS = 8
FOX_HEAD_DIM = 64
FOX_WIDTH = FOX_HEADS * FOX_HEAD_DIM
DIFF_HEADS = 4
DIFF_QK_DIM = 64
DIFF_V_DIM = 2 * DIFF_QK_DIM
DIFF_WIDTH = DIFF_HEADS * DIFF_V_DIM
BRANCH_WIDTH = 512
N_BRANCHES = 2

BLOCK_Q = 128
ROPE_THETA = 10000.0
NORM_EPS = 1e-6
SUBLN_EPS = 1e-5

SPLIT_SIZES = [
    FOX_WIDTH,
    FOX_WIDTH,
    FOX_WIDTH,
    FOX_HEADS,
    FOX_WIDTH,
    DIFF_HEADS * 2 * DIFF_QK_DIM,
    DIFF_HEADS * 2 * DIFF_QK_DIM,
    DIFF_WIDTH,
    DIFF_WIDTH,
    N_BRANCHES * D_MODEL,
]
N_IN = sum(SPLIT_SIZES)
SPLIT_POINTS = [int(v) for v in np.cumsum(SPLIT_SIZES)[:-1]]

kernel_name = "hybrid_fox_diffattn_gated_merge"


def lambda_init_for(layer_idx):
    return 0.8 - 0.6 * math.exp(-0.3 * (layer_idx - 1))


def rms_norm(x, g, eps):
    xf = x.astype(jnp.float32)
    y = xf * lax.rsqrt(jnp.mean(xf * xf, axis=-1, keepdims=True) + eps)
    return (y * g.astype(jnp.float32)).astype(x.dtype)


def rope_tables(seq, dim):
    pos = jnp.arange(seq, dtype=jnp.float32)
    inv_freq = ROPE_THETA ** (-jnp.arange(0, dim, 2, dtype=jnp.float32) / dim)
    ang = pos[:, None] * inv_freq[None, :]
    return jnp.cos(ang), jnp.sin(ang)


def apply_rope(x, cos, sin):
    x1, x2 = jnp.split(x, 2, axis=-1)
    c = cos.astype(x.dtype)
    s = sin.astype(x.dtype)
    return jnp.concatenate([x1 * c - x2 * s, x2 * c + x1 * s], axis=-1)


def split_heads(t, n_heads):
    b, s, _ = t.shape
    return t.reshape(b, s, n_heads, -1).transpose(0, 2, 1, 3)


def merge_heads(t):
    b, h, s, d = t.shape
    return t.transpose(0, 2, 1, 3).reshape(b, s, h * d)


def fox_attention(q, k, v, log_f):
    b, h, s, d = q.shape
    nb = s // BLOCK_Q
    scale = 1.0 / math.sqrt(d)
    c = jnp.cumsum(log_f, axis=-1)
    qb = q.reshape(b, h, nb, BLOCK_Q, d).transpose(2, 0, 1, 3, 4)
    cb = c.reshape(b, h, nb, BLOCK_Q).transpose(2, 0, 1, 3)
    kpos = jnp.arange(s)

    def step(args):
        i, qi, ci = args
        qpos = i * BLOCK_Q + jnp.arange(BLOCK_Q)
        logits = jnp.einsum('bhqd,bhkd->bhqk', qi, k).astype(jnp.float32) * scale
        logits = logits + ci[..., :, None] - c[..., None, :]
        logits = jnp.where(kpos[None, :] <= qpos[:, None], logits, -jnp.inf)
        p = jax.nn.softmax(logits, axis=-1)
        return jnp.einsum('bhqk,bhkd->bhqd', p.astype(v.dtype), v)

    out = lax.map(step, (jnp.arange(nb), qb, cb))
    return out.transpose(1, 2, 0, 3, 4).reshape(b, h, s, d)


def diff_attention(q, k, v, lam):
    b, h, _, s, d = q.shape
    nb = s // BLOCK_Q
    scale = 1.0 / math.sqrt(d)
    qb = q.reshape(b, h, 2, nb, BLOCK_Q, d).transpose(3, 0, 1, 2, 4, 5)
    kpos = jnp.arange(s)

    def step(args):
        i, qi = args
        qpos = i * BLOCK_Q + jnp.arange(BLOCK_Q)
        logits = jnp.einsum('bhmqd,bhmkd->bhmqk', qi, k).astype(jnp.float32) * scale
        logits = jnp.where(kpos[None, :] <= qpos[:, None], logits, -jnp.inf)
        p = jax.nn.softmax(logits, axis=-1)
        pd = p[:, :, 0] - lam * p[:, :, 1]
        return jnp.einsum('bhqk,bhkd->bhqd', pd.astype(v.dtype), v)

    out = lax.map(step, (jnp.arange(nb), qb))
    return out.transpose(1, 2, 0, 3, 4).reshape(b, h, s, v.shape[-1])


def setup_inputs(seed: int = 0) -> dict:
    key = jax.random.key(seed)
    ks = jax.random.split(key, 13)
    f32 = jnp.float32
    x = jax.random.normal(ks[0], (BATCH, SEQ, D_MODEL), f32)
    g_pre = 1.0 + 0.1 * jax.random.normal(ks[1], (DEPTH, D_MODEL), f32)
    w_in = jax.random.normal(ks[2], (DEPTH, D_MODEL, N_IN), f32) * D_MODEL ** -0.5
    b_forget = jax.random.uniform(ks[3], (DEPTH, FOX_HEADS), f32, minval=1.0, maxval=5.0)
    lambda_q1 = 0.1 * jax.random.normal(ks[4], (DEPTH, DIFF_QK_DIM), f32)
    lambda_k1 = 0.1 * jax.random.normal(ks[5], (DEPTH, DIFF_QK_DIM), f32)
    lambda_q2 = 0.1 * jax.random.normal(ks[6], (DEPTH, DIFF_QK_DIM), f32)
    lambda_k2 = 0.1 * jax.random.normal(ks[7], (DEPTH, DIFF_QK_DIM), f32)
    g_subln = 1.0 + 0.1 * jax.random.normal(ks[8], (DEPTH, DIFF_V_DIM), f32)
    w_branch = jax.random.normal(ks[9], (DEPTH, N_BRANCHES, BRANCH_WIDTH, D_MODEL), f32) * BRANCH_WIDTH ** -0.5
    w_out = jax.random.normal(ks[10], (DEPTH, D_MODEL, D_MODEL), f32) * D_MODEL ** -0.5
    g_post = 1.0 + 0.1 * jax.random.normal(ks[11], (DEPTH, D_MODEL), f32)
    return {"x": x, "g_pre": g_pre, "w_in": w_in, "b_forget": b_forget,
            "lambda_q1": lambda_q1, "lambda_k1": lambda_k1,
            "lambda_q2": lambda_q2, "lambda_k2": lambda_k2,
            "g_subln": g_subln, "w_branch": w_branch, "w_out": w_out,
            "g_post": g_post}


def reference(x, g_pre, w_in, b_forget, lambda_q1, lambda_k1, lambda_q2, lambda_k2,
              g_subln, w_branch, w_out, g_post):
    b, s, _ = x.shape
    cos, sin = rope_tables(s, DIFF_QK_DIM)
    for l in range(DEPTH):
        lam_init = lambda_init_for(l + 1)
        h = rms_norm(x, g_pre[l], NORM_EPS)
        proj = jnp.einsum('bsd,dn->bsn', h, w_in[l])
        qa, ka, va, fa, za, qb, kb, vb, zb, gates = jnp.split(proj, SPLIT_POINTS, axis=-1)

        log_f = jax.nn.log_sigmoid((fa + b_forget[l]).astype(jnp.float32)).transpose(0, 2, 1)
        ya = fox_attention(split_heads(qa, FOX_HEADS), split_heads(ka, FOX_HEADS),
                           split_heads(va, FOX_HEADS), log_f)
        ya = merge_heads(ya) * jax.nn.silu(za)

        qd = apply_rope(qb.reshape(b, s, DIFF_HEADS, 2, DIFF_QK_DIM).transpose(0, 2, 3, 1, 4), cos, sin)
        kd = apply_rope(kb.reshape(b, s, DIFF_HEADS, 2, DIFF_QK_DIM).transpose(0, 2, 3, 1, 4), cos, sin)
        vd = split_heads(vb, DIFF_HEADS)
        lam = (jnp.exp(jnp.sum(lambda_q1[l].astype(jnp.float32) * lambda_k1[l].astype(jnp.float32)))
               - jnp.exp(jnp.sum(lambda_q2[l].astype(jnp.float32) * lambda_k2[l].astype(jnp.float32)))
               + lam_init)
        yb = diff_attention(qd, kd, vd, lam)
        yb = rms_norm(yb, g_subln[l], SUBLN_EPS) * (1.0 - lam_init)
        yb = merge_heads(yb) * jax.nn.silu(zb)

        gate_a, gate_b = jnp.split(jax.nn.sigmoid(gates), N_BRANCHES, axis=-1)
        merged = (gate_a * jnp.einsum('bsw,wd->bsd', ya, w_branch[l, 0])
                  + gate_b * jnp.einsum('bsw,wd->bsd', yb, w_branch[l, 1]))
        y = jnp.einsum('bsd,de->bse', merged, w_out[l])
        x = x + rms_norm(y, g_post[l], NORM_EPS)
    return x
```

```cpp
#include <hip/hip_runtime.h>
#include <hip/hip_cooperative_groups.h>
#include <cstdio>
#include <cstdint>
namespace cg = cooperative_groups;
namespace pg8 {
#define PG8_LAS __attribute__((address_space(3)))
typedef unsigned short bf16_t;
typedef short bf16x8 __attribute__((ext_vector_type(8)));
typedef float f32x4 __attribute__((ext_vector_type(4)));
typedef unsigned u32x4 __attribute__((ext_vector_type(4)));
constexpr int BM = 256, BK = 64, HALF = 128, HTB = HALF * BK * 2  , STAGE_BYTES = 8 * HTB, NXCD = 8, WGM = 8;

__host__ __device__ __forceinline__ int lds_byte(int r, int c) { const int st = (r >> 4) * 2 + (c >> 5), rr = r & 15, cc = c & 31, ob = rr * 64 + cc * 2; return st * 1024 + (ob ^ (((ob >> 9) & 1) << 5)); }
__host__ __device__ __forceinline__ void stage_rc(int b, int& R, int& C) { const int st = b / 1024, sb = b % 1024, swz = sb ^ (((sb >> 9) & 1) << 5); R = (st >> 1) * 16 + swz / 64; C = (st & 1) * 32 + (swz % 64) / 2; }
__host__ __device__ __forceinline__ int perm32(int rho) { const int n = rho >> 4, i = rho & 15; return 8 * (i >> 2) + 4 * n + (i & 3); }

struct Unit { int pm, pn; };
struct Gemm { const bf16_t* A; const bf16_t* Bt; int M, N, K; };

struct StaticOrder {
    int nM, nN, nwg, G, c;
    __host__ __device__ void init(int M, int N, int G_, int c_) { nM = M / BM; nN = N / BM; nwg = nM * nN; G = G_; c = c_; }
    __host__ __device__ bool next(int i, Unit& u) const {
        const long L = (long)i * G + c; if (L >= nwg) return false;
        int wgid = (int)L; { const int q = nwg / NXCD, r = nwg % NXCD, xcd = wgid % NXCD, off = wgid / NXCD; wgid = (xcd < r ? xcd * (q + 1) : r * (q + 1) + (xcd - r) * q) + off; }
        const int nig = WGM * nN, gid = wgid / nig, fm = gid * WGM, gsz = (nM - fm) < WGM ? (nM - fm) : WGM;
        u.pm = fm + ((wgid % nig) % gsz); u.pn = (wgid % nig) / gsz; return true;
    }
    __device__ __forceinline__ void a_ready(const Unit&) const {}
    __device__ __forceinline__ void done(const Unit&) const {}
};

__device__ __forceinline__ unsigned cvt_pk_bf16(float lo, float hi) { unsigned r; asm volatile("v_cvt_pk_bf16_f32 %0, %1, %2" : "=v"(r) : "v"(lo), "v"(hi)); return r; }
typedef float f32x2 __attribute__((ext_vector_type(2)));
__device__ __forceinline__ f32x2 gelu_pk(f32x2 v) {
    const f32x2 av = __builtin_elementwise_abs(v), d = av * 0.2316418882f + 1.0f;
    f32x2 t; t.x = __builtin_amdgcn_rcpf(d.x); t.y = __builtin_amdgcn_rcpf(d.y);
    f32x2 q = t * 0.5307027145f + (-0.7265760135f); q = q * t + 0.7107068705f; q = q * t + (-0.142248368f); q = q * t + 0.127414796f; q = q * t;
    const f32x2 s = (v * v) * (-0.72134752044f);
    f32x2 e; e.x = __builtin_amdgcn_exp2f(s.x); e.y = __builtin_amdgcn_exp2f(s.y);
    const f32x2 m = v * (q * e), r = v - m;
    f32x2 o; o.x = v.x < 0.f ? m.x : r.x; o.y = v.y < 0.f ? m.y : r.y; return o;
}

template <int ACT  > struct EpiBf16 {
    static constexpr bool PERM = true, AFTER_DRAIN = false; static_assert(ACT == 0 || ACT == 1, "EpiBf16: ACT is 0 (none) or 1 (gelu_pk)");
    bf16_t* O; int ldc; const float* bias; int split_cols; size_t split_stride; float scale0;
    __device__ __forceinline__ void operator()(const f32x4 (&acc)[2][2][4][2], const Unit& u, int wr, int wc, int fr, int fq) const {
        const int row0 = u.pm * BM + wr * 64 + fr; int colt = u.pn * BM; bf16_t* base = O;
        float sc = 1.f; if (split_cols) { const int t = colt / split_cols; base += (size_t)t * split_stride; colt -= t * split_cols; if (t == 0) sc = scale0; }
        const int col0 = colt + wc * 32 + 8 * fq, bcol0 = u.pn * BM + wc * 32 + 8 * fq;
        f32x4 bv[2][2];
#pragma unroll
        for (int bj = 0; bj < 2; ++bj)
#pragma unroll
            for (int n = 0; n < 2; ++n) bv[bj][n] = bias ? *(const f32x4*)(bias + bcol0 + bj * HALF + 4 * n) : (f32x4){0.f, 0.f, 0.f, 0.f};
#pragma unroll
        for (int ai = 0; ai < 2; ++ai)
#pragma unroll
            for (int m = 0; m < 4; ++m) { bf16_t* rowp = base + (size_t)(row0 + ai * HALF + m * 16) * ldc + col0;
#pragma unroll
                for (int bj = 0; bj < 2; ++bj) { f32x4 v0 = acc[ai][bj][m][0] + bv[bj][0], v1 = acc[ai][bj][m][1] + bv[bj][1];
                    if (ACT == 1) { f32x2 a = gelu_pk((f32x2){v0[0], v0[1]}), b = gelu_pk((f32x2){v0[2], v0[3]}), c = gelu_pk((f32x2){v1[0], v1[1]}), d = gelu_pk((f32x2){v1[2], v1[3]});
                        v0 = (f32x4){a.x, a.y, b.x, b.y}; v1 = (f32x4){c.x, c.y, d.x, d.y}; }
                    v0 = v0 * sc; v1 = v1 * sc; u32x4 w; w.x = cvt_pk_bf16(v0[0], v0[1]); w.y = cvt_pk_bf16(v0[2], v0[3]); w.z = cvt_pk_bf16(v1[0], v1[1]); w.w = cvt_pk_bf16(v1[2], v1[3]);
                    *(u32x4*)(rowp + bj * HALF) = w; } }
    }
};

template <class Epi, class Sched, bool ALIGN_EPI = false, bool SP2 = false>
__device__ __forceinline__ void gemm_phase(PG8_LAS unsigned char* lds, const Gemm g, const Sched& S, const Epi& E, const int wv  ) {
    int lane_; asm volatile("v_mbcnt_lo_u32_b32 %0, -1, 0\n\tv_mbcnt_hi_u32_b32 %0, -1, %0" : "=v"(lane_));
    const int tid_ = wv * 64 + lane_;
    const int tid = tid_, wid = __builtin_amdgcn_readfirstlane(tid >> 6), lane = tid & 63, wr = wid >> 2, wc = wid & 3, fr = lane & 15, fq = lane >> 4;
    const int K = g.K, nt = K / BK;
    unsigned voffA[2], voffB[2];
#pragma unroll
    for (int i = 0; i < 2; ++i) { int R, C; stage_rc(tid * 16 + i * 8192, R, C); const int Rb = Epi::PERM ? ((R & ~31) + perm32(R & 31)) : R;
        voffA[i] = (unsigned)(R * K + C) * 2u; voffB[i] = (unsigned)(Rb * K + C) * 2u; }
    const size_t kstep = (size_t)(BK * 2);
    const size_t hstep = (size_t)HALF * K * 2;
    const size_t tstep = 2 * hstep;
    const unsigned ldsw = (unsigned)wid * 1024u;
    const int aoff = lds_byte(wr * 64 + fr, fq * 8), boff = lds_byte(wc * 32 + fr, fq * 8);
#define PG8_SA(b, h) (((b) * 2 + (h)) * HTB)
#define PG8_SB(b, h) ((4 + (b) * 2 + (h)) * HTB)
#define PG8_STAGE(bufoff, gbase, voff) do { _Pragma("unroll") for (int _i = 0; _i < 2; ++_i) \
        __builtin_amdgcn_global_load_lds((const unsigned*)((const char*)(gbase) + (voff)[_i]), (PG8_LAS unsigned*)(lds + (bufoff) + ldsw + _i * 8192), 16, 0, 0); } while (0)
#define PG8_LDA(dst, b, h) do { _Pragma("unroll") for (int m = 0; m < 4; ++m) _Pragma("unroll") for (int k = 0; k < 2; ++k) dst[m][k] = *(const PG8_LAS bf16x8*)(lds + PG8_SA(b, h) + aoff + m * 2048 + k * 1024); } while (0)
#define PG8_LDB(dst, b, h) do { _Pragma("unroll") for (int n = 0; n < 2; ++n) _Pragma("unroll") for (int k = 0; k < 2; ++k) dst[n][k] = *(const PG8_LAS bf16x8*)(lds + PG8_SB(b, h) + boff + n * 2048 + k * 1024); } while (0)
#define PG8_MMA(ai, bj, At, Bt) do { __builtin_amdgcn_s_setprio(1); _Pragma("unroll") for (int m = 0; m < 4; ++m) _Pragma("unroll") for (int n = 0; n < 2; ++n) _Pragma("unroll") for (int k = 0; k < 2; ++k) \
        acc[ai][bj][m][n] = __builtin_amdgcn_mfma_f32_16x16x32_bf16(Bt[n][k], At[m][k], acc[ai][bj][m][n], 0, 0, 0); __builtin_amdgcn_s_setprio(0); } while (0)
#define PG8_WAIT_V(n) asm volatile("s_waitcnt vmcnt(" #n ")" ::: "memory")
#define PG8_WAIT_L(n) asm volatile("s_waitcnt lgkmcnt(" #n ")" ::: "memory")
#define PG8_BAR __builtin_amdgcn_s_barrier()
#define PG8_SCHED __builtin_amdgcn_sched_barrier(0)
    Unit cur, nxt; int ui = 0;
    if (!S.next(0, cur)) return;
    f32x4 acc[2][2][4][2];
#pragma unroll
    for (int a = 0; a < 2; ++a)
#pragma unroll
        for (int b = 0; b < 2; ++b)
#pragma unroll
            for (int m = 0; m < 4; ++m)
#pragma unroll
                for (int n = 0; n < 2; ++n) acc[a][b][m][n] = (f32x4){0.f, 0.f, 0.f, 0.f};
    bf16x8 At[4][2], B0[2][2], B1[2][2];
    const char* cA = (const char*)g.A + (size_t)cur.pm * tstep; const char* cB = (const char*)g.Bt + (size_t)cur.pn * tstep;
    S.a_ready(cur);
    if constexpr (SP2) {
        PG8_STAGE(PG8_SB(0, 0), cB, voffB); PG8_STAGE(PG8_SB(0, 1), cB + hstep, voffB); PG8_STAGE(PG8_SA(0, 0), cA, voffA); PG8_STAGE(PG8_SA(0, 1), cA + hstep, voffA);
        if (wr == 1) PG8_BAR;
        PG8_WAIT_V(2); PG8_BAR;
        PG8_STAGE(PG8_SB(1, 0), cB + kstep, voffB); PG8_STAGE(PG8_SA(1, 0), cA + kstep, voffA); PG8_STAGE(PG8_SB(1, 1), cB + hstep + kstep, voffB);
        PG8_WAIT_V(6); PG8_BAR;
    } else {
        PG8_STAGE(PG8_SB(0, 0), cB, voffB); PG8_STAGE(PG8_SA(0, 0), cA, voffA); PG8_STAGE(PG8_SB(0, 1), cB + hstep, voffB); PG8_STAGE(PG8_SA(0, 1), cA + hstep, voffA);
        if (wr == 1) PG8_BAR;
        PG8_WAIT_V(4); PG8_BAR;
        PG8_STAGE(PG8_SB(1, 0), cB + kstep, voffB); PG8_STAGE(PG8_SA(1, 0), cA + kstep, voffA); PG8_STAGE(PG8_SB(1, 1), cB + hstep + kstep, voffB);
        PG8_WAIT_V(6); PG8_BAR;
    }
    for (;;) {
        const bool has_next = S.next(ui + 1, nxt);
        const char* nA = has_next ? (const char*)g.A + (size_t)nxt.pm * tstep : cA; const char* nB = has_next ? (const char*)g.Bt + (size_t)nxt.pn * tstep : cB;
        for (int t = 0; t < nt; t += 2) {
            const bool last = (t == nt - 2);
            const char* a1 = cA + (size_t)(t + 1) * kstep;
            const char* a2 = last ? nA : cA + (size_t)(t + 2) * kstep; const char* b2 = last ? nB : cB + (size_t)(t + 2) * kstep;
            const char* a3 = a2 + kstep; const char* b3 = b2 + kstep;
            if (last && has_next) S.a_ready(nxt);
            if constexpr (SP2) {
            PG8_LDB(B0, 0, 0); PG8_LDB(B1, 0, 1); PG8_SCHED; PG8_LDA(At, 0, 0); PG8_STAGE(PG8_SA(1, 1), a1 + hstep, voffA);
            PG8_WAIT_V(8); PG8_WAIT_L(0); PG8_BAR; PG8_MMA(0, 0, At, B0); PG8_MMA(0, 1, At, B1); PG8_BAR; PG8_SCHED;
            PG8_LDA(At, 0, 1); PG8_STAGE(PG8_SB(0, 0), b2, voffB); PG8_STAGE(PG8_SB(0, 1), b2 + hstep, voffB); PG8_STAGE(PG8_SA(0, 0), a2, voffA);
            PG8_WAIT_V(8); PG8_WAIT_L(0); PG8_BAR; PG8_MMA(1, 0, At, B0); PG8_MMA(1, 1, At, B1); PG8_BAR; PG8_SCHED;
            PG8_LDB(B0, 1, 0); PG8_LDB(B1, 1, 1); PG8_SCHED; PG8_LDA(At, 1, 0); PG8_STAGE(PG8_SA(0, 1), a2 + hstep, voffA);
            PG8_WAIT_V(8); PG8_WAIT_L(0); PG8_BAR; PG8_MMA(0, 0, At, B0); PG8_MMA(0, 1, At, B1); PG8_BAR; PG8_SCHED;
            PG8_LDA(At, 1, 1); PG8_STAGE(PG8_SB(1, 0), b3, voffB); PG8_STAGE(PG8_SB(1, 1), b3 + hstep, voffB); PG8_STAGE(PG8_SA(1, 0), a3, voffA);
            PG8_WAIT_V(8); PG8_WAIT_L(0); PG8_BAR; PG8_MMA(1, 0, At, B0); PG8_MMA(1, 1, At, B1); PG8_BAR; PG8_SCHED;
            } else {
            PG8_LDB(B0, 0, 0); PG8_SCHED; PG8_LDA(At, 0, 0); PG8_STAGE(PG8_SA(1, 1), a1 + hstep, voffA);
            PG8_WAIT_L(8); PG8_BAR; PG8_WAIT_L(0); PG8_MMA(0, 0, At, B0); PG8_BAR; PG8_SCHED;
            PG8_LDB(B1, 0, 1); PG8_STAGE(PG8_SB(0, 0), b2, voffB);
            PG8_BAR; PG8_WAIT_L(0); PG8_MMA(0, 1, At, B1); PG8_BAR;
            PG8_LDA(At, 0, 1); PG8_STAGE(PG8_SA(0, 0), a2, voffA);
            PG8_BAR; PG8_WAIT_L(0); PG8_MMA(1, 0, At, B0); PG8_BAR; PG8_SCHED;
            PG8_STAGE(PG8_SB(0, 1), b2 + hstep, voffB);
            PG8_WAIT_V(6); PG8_BAR; PG8_MMA(1, 1, At, B1); PG8_BAR;
            PG8_LDB(B0, 1, 0); PG8_SCHED; PG8_LDA(At, 1, 0); PG8_STAGE(PG8_SA(0, 1), a2 + hstep, voffA);
            PG8_WAIT_L(8); PG8_BAR; PG8_WAIT_L(0); PG8_MMA(0, 0, At, B0); PG8_BAR; PG8_SCHED;
            PG8_LDB(B1, 1, 1); PG8_STAGE(PG8_SB(1, 0), b3, voffB);
            PG8_BAR; PG8_WAIT_L(0); PG8_MMA(0, 1, At, B1); PG8_BAR;
            PG8_LDA(At, 1, 1); PG8_STAGE(PG8_SA(1, 0), a3, voffA);
            PG8_BAR; PG8_WAIT_L(0); PG8_MMA(1, 0, At, B0); PG8_BAR; PG8_SCHED;
            PG8_STAGE(PG8_SB(1, 1), b3 + hstep, voffB);
            PG8_WAIT_V(6); PG8_BAR; PG8_MMA(1, 1, At, B1); PG8_BAR;
            }
        }
        if constexpr (ALIGN_EPI) { if (wr == 0) PG8_BAR; }
        if constexpr (!Epi::AFTER_DRAIN) { E(acc, cur, wr, wc, fr, fq); S.done(cur); }
        if (!has_next) break;
#pragma unroll
        for (int a = 0; a < 2; ++a)
#pragma unroll
            for (int b = 0; b < 2; ++b)
#pragma unroll
                for (int m = 0; m < 4; ++m)
#pragma unroll
                    for (int n = 0; n < 2; ++n) acc[a][b][m][n] = (f32x4){0.f, 0.f, 0.f, 0.f};
        cur = nxt; cA = nA; cB = nB; ++ui;
        if constexpr (ALIGN_EPI) { if (wr == 1) PG8_BAR; }
    }
    PG8_WAIT_V(0);
    if constexpr (!ALIGN_EPI) { if (wr == 0) PG8_BAR; }
    PG8_BAR;
    if constexpr (Epi::AFTER_DRAIN) { E.fused(acc, cur, wr, wc, fr, fq, lds, wid, lane); S.done(cur); }
#undef PG8_SA
#undef PG8_SB
#undef PG8_STAGE
#undef PG8_LDA
#undef PG8_LDB
#undef PG8_MMA
#undef PG8_WAIT_V
#undef PG8_WAIT_L
#undef PG8_BAR
#undef PG8_SCHED
}
}

#define LAS __attribute__((address_space(3)))
namespace mk {
using pg8::bf16_t; using pg8::f32x4; using pg8::u32x4; using pg8::Unit;
typedef short bf16x8 __attribute__((ext_vector_type(8)));
typedef short s16x4 __attribute__((ext_vector_type(4)));
typedef float f32x16 __attribute__((ext_vector_type(16)));
typedef unsigned u32x2 __attribute__((ext_vector_type(2)));

constexpr int M = 65536, DM = 1024, SEQ = 8192, NBATCH = 8, NIN = 6152, N1 = 6144, NITEMS = 3072;
constexpr size_t MiB = (size_t)1 << 20;
constexpr size_t WS_CTL = 0, WS_BT1 = 1 * MiB, WS_BT3A = 13 * MiB, WS_BT3B = 15 * MiB, WS_COS = 17 * MiB, WS_SIN = 18 * MiB, WS_LOGF = 19 * MiB, WS_CB = 21 * MiB,
                 WS_SSQ = 23 * MiB, WS_PARK = 24 * MiB, WS_ITEMS = 56 * MiB, WS_KN2 = 57 * MiB, WS_G = 64 * MiB, WS_QKV = 320 * MiB, WS_Z = 704 * MiB, WS_H = 832 * MiB, WS_Y = WS_H,
                 WS_T = 320 * MiB, WS_MERGED = 576 * MiB, WS_END = 960 * MiB;
constexpr size_t SB = (size_t)NBATCH * 8 * SEQ * 64;
constexpr float C2 = 0.125f * 1.4426950408889634f;
constexpr float LOG2E = 1.4426950408889634f;
constexpr int LDS_BYTES = 131072 + 256;

__device__ __forceinline__ unsigned pk_bf16(float lo, float hi) {
    typedef float f32x2_t __attribute__((ext_vector_type(2))); typedef __bf16 bf16x2_t __attribute__((ext_vector_type(2)));
    f32x2_t v = {lo, hi}; bf16x2_t b = __builtin_convertvector(v, bf16x2_t); return __builtin_bit_cast(unsigned, b); }
__device__ __forceinline__ bf16_t bf16_1(float v) { return (bf16_t)(pk_bf16(v, 0.f) & 0xffffu); }
__device__ __forceinline__ float bf_lo(unsigned w) { return __uint_as_float(w << 16); }
__device__ __forceinline__ float bf_hi(unsigned w) { return __uint_as_float(w & 0xffff0000u); }
__device__ __forceinline__ float bf1(bf16_t v) { return __uint_as_float((unsigned)v << 16); }
__device__ __forceinline__ float sigmoid_(float v) { return __builtin_amdgcn_rcpf(1.f + __expf(-v)); }
__device__ __forceinline__ float silu_(float v) { return v * sigmoid_(v); }
__device__ __forceinline__ u32x4 pack8(const f32x4 a, const f32x4 b) { u32x4 w; w.x = pk_bf16(a[0], a[1]); w.y = pk_bf16(a[2], a[3]); w.z = pk_bf16(b[0], b[1]); w.w = pk_bf16(b[2], b[3]); return w; }

struct Epi1 {
    static constexpr bool PERM = true, AFTER_DRAIN = false;
    bf16_t* qkv; bf16_t* z; bf16_t* g; const float* cs; const float* sn; float* kn2;
    __device__ __forceinline__ void operator()(const f32x4 (&acc)[2][2][4][2], const Unit& u, int wr, int wc, int fr, int fq) const {
        const int pn = u.pn; const int row0 = u.pm * 256 + wr * 64 + fr; const int ct = wc * 32 + 8 * fq;
        if (pn >= 16) {
#pragma unroll
            for (int ai = 0; ai < 2; ++ai)
#pragma unroll
                for (int m = 0; m < 4; ++m) { const int row = row0 + ai * 128 + m * 16; bf16_t* rp = g + (size_t)row * 2048 + (pn - 16) * 256 + ct;
#pragma unroll
                    for (int bj = 0; bj < 2; ++bj) { f32x4 v0 = acc[ai][bj][m][0], v1 = acc[ai][bj][m][1];
#pragma unroll
                        for (int i = 0; i < 4; ++i) { v0[i] = sigmoid_(v0[i]); v1[i] = sigmoid_(v1[i]); }
                        *(u32x4*)(rp + bj * 128) = pack8(v0, v1); } }
        } else if ((pn & 7) >= 6) {
            bf16_t* zz = z + (pn >= 8 ? (size_t)M * 512 : (size_t)0);
#pragma unroll
            for (int ai = 0; ai < 2; ++ai)
#pragma unroll
                for (int m = 0; m < 4; ++m) { const int row = row0 + ai * 128 + m * 16; bf16_t* rp = zz + (size_t)row * 512 + (pn & 1) * 256 + ct;
#pragma unroll
                    for (int bj = 0; bj < 2; ++bj) { f32x4 v0 = acc[ai][bj][m][0], v1 = acc[ai][bj][m][1];
#pragma unroll
                        for (int i = 0; i < 4; ++i) { v0[i] = silu_(v0[i]); v1[i] = silu_(v1[i]); }
                        *(u32x4*)(rp + bj * 128) = pack8(v0, v1); } }
        } else if (pn >= 8 && pn < 12) {
            bf16_t* buf = qkv + (size_t)(pn < 10 ? 3 : 4) * SB; const float sc = pn < 10 ? C2 : 1.f;
#pragma unroll
            for (int ai = 0; ai < 2; ++ai)
#pragma unroll
                for (int m = 0; m < 4; ++m) { const int row = row0 + ai * 128 + m * 16; const int b = row >> 13, s = row & (SEQ - 1);
#pragma unroll
                    for (int bj = 0; bj < 2; ++bj) { const int colp = (pn & 1) * 256 + bj * 128 + ct; const int strm = colp >> 6, a = (colp & 63) >> 3;
                        const f32x4 c4 = *(const f32x4*)(cs + s * 32 + 4 * a), s4 = *(const f32x4*)(sn + s * 32 + 4 * a);
                        const f32x4 v0 = acc[ai][bj][m][0], v1 = acc[ai][bj][m][1];
                        const f32x4 lo = (v0 * c4 - v1 * s4) * sc, hi = (v1 * c4 + v0 * s4) * sc;
                        bf16_t* dst = buf + ((size_t)(b * 8 + strm) * SEQ + s) * 64 + 4 * a;
                        u32x2 w0, w1; w0.x = pk_bf16(lo[0], lo[1]); w0.y = pk_bf16(lo[2], lo[3]); w1.x = pk_bf16(hi[0], hi[1]); w1.y = pk_bf16(hi[2], hi[3]);
                        *(u32x2*)dst = w0; *(u32x2*)(dst + 32) = w1; } }
        } else {
            bf16_t* buf = qkv + (size_t)(pn >= 12 ? 5 : (pn >> 1)) * SB; const float sc = pn < 2 ? C2 : 1.f;
#pragma unroll
            for (int ai = 0; ai < 2; ++ai)
#pragma unroll
                for (int m = 0; m < 4; ++m) { const int row = row0 + ai * 128 + m * 16; const int b = row >> 13, s = row & (SEQ - 1);
#pragma unroll
                    for (int bj = 0; bj < 2; ++bj) { const int colp = (pn & 1) * 256 + bj * 128 + ct; const int strm = colp >> 6, d = colp & 63;
                        const f32x4 v0 = acc[ai][bj][m][0] * sc, v1 = acc[ai][bj][m][1] * sc;
                        *(u32x4*)(buf + ((size_t)(b * 8 + strm) * SEQ + s) * 64 + d) = pack8(v0, v1);
                        if (pn == 2 || pn == 3) {
                            float ps = (v0[0] * v0[0] + v0[1] * v0[1]) + (v0[2] * v0[2] + v0[3] * v0[3]) + (v1[0] * v1[0] + v1[1] * v1[1]) + (v1[2] * v1[2] + v1[3] * v1[3]);
                            ps += __shfl_xor(ps, 16); ps += __shfl_xor(ps, 32);
                            if (fq == 0) atomicAdd(kn2 + (size_t)(b * 8 + strm) * SEQ + s, ps); } } }
        }
    }
};

struct Sched3a {
    pg8::StaticOrder so;
    __device__ bool next(int i, Unit& u) const { if (!so.next(i >> 1, u)) return false; const int br = i & 1; u.pm += 256 * br; u.pn += 4 * br; return true; }
    __device__ __forceinline__ void a_ready(const Unit&) const {}
    __device__ __forceinline__ void done(const Unit&) const {}
};
struct Epi3a {
    static constexpr bool PERM = true, AFTER_DRAIN = false;
    const bf16_t* g; bf16_t* T; bf16_t* merged;
    __device__ __forceinline__ void operator()(const f32x4 (&acc)[2][2][4][2], const Unit& u, int wr, int wc, int fr, int fq) const {
        const int br = u.pm >= 256 ? 1 : 0; const int pm = u.pm - 256 * br, pn = u.pn - 4 * br;
        const int row0 = pm * 256 + wr * 64 + fr; const int col0 = pn * 256 + wc * 32 + 8 * fq;
#pragma unroll
        for (int ai = 0; ai < 2; ++ai)
#pragma unroll
            for (int m = 0; m < 4; ++m) { const int row = row0 + ai * 128 + m * 16;
#pragma unroll
                for (int bj = 0; bj < 2; ++bj) { const int col = col0 + bj * 128;
                    const u32x4 gw = *(const u32x4*)(g + (size_t)row * 2048 + br * 1024 + col);
                    const f32x4 g0 = {bf_lo(gw.x), bf_hi(gw.x), bf_lo(gw.y), bf_hi(gw.y)}, g1 = {bf_lo(gw.z), bf_hi(gw.z), bf_lo(gw.w), bf_hi(gw.w)};
                    bf16_t* tp = T + (size_t)row * 1024 + col;
                    if (br == 0) { *(u32x4*)tp = pack8(g0 * acc[ai][bj][m][0], g1 * acc[ai][bj][m][1]); }
                    else { const u32x4 tw = *(const u32x4*)tp;
                        const f32x4 t0 = {bf_lo(tw.x), bf_hi(tw.x), bf_lo(tw.y), bf_hi(tw.y)}, t1 = {bf_lo(tw.z), bf_hi(tw.z), bf_lo(tw.w), bf_hi(tw.w)};
                        *(u32x4*)(merged + (size_t)row * 1024 + col) = pack8(t0 + g0 * acc[ai][bj][m][0], t1 + g1 * acc[ai][bj][m][1]); } } }
    }
};
struct Epi3b {
    static constexpr bool PERM = true, AFTER_DRAIN = false;
    bf16_t* y; float* ssq;
    __device__ __forceinline__ void operator()(const f32x4 (&acc)[2][2][4][2], const Unit& u, int wr, int wc, int fr, int fq) const {
        const int row0 = u.pm * 256 + wr * 64 + fr; const int col0 = u.pn * 256 + wc * 32 + 8 * fq;
#pragma unroll
        for (int ai = 0; ai < 2; ++ai)
#pragma unroll
            for (int m = 0; m < 4; ++m) { const int row = row0 + ai * 128 + m * 16; float s = 0.f;
#pragma unroll
                for (int bj = 0; bj < 2; ++bj) { const f32x4 v0 = acc[ai][bj][m][0], v1 = acc[ai][bj][m][1];
                    *(u32x4*)(y + (size_t)row * 1024 + col0 + bj * 128) = pack8(v0, v1);
                    s += (v0[0] * v0[0] + v0[1] * v0[1]) + (v0[2] * v0[2] + v0[3] * v0[3]) + (v1[0] * v1[0] + v1[1] * v1[1]) + (v1[2] * v1[2] + v1[3] * v1[3]); }
                s += __shfl_xor(s, 16); s += __shfl_xor(s, 32);
                if (fq == 0) atomicAdd(ssq + row, s); }
    }
};

constexpr int A_KB = 8448  , A_VBASE = 2 * A_KB, A_VB = 16384, A_WSF = A_VBASE + 2 * A_VB, A_MISC = A_WSF + 8 * 128;
typedef short v4i16_t __attribute__((ext_vector_type(4)));
__device__ __forceinline__ s16x4 tr_read(LAS unsigned char* p) { return __builtin_bit_cast(s16x4, __builtin_amdgcn_ds_read_tr16_b64_v4i16((LAS v4i16_t*)p)); }
__device__ __forceinline__ float half_max(float m) { auto rr = __builtin_amdgcn_permlane32_swap(__float_as_uint(m), __float_as_uint(m), false, false); return fmaxf(__uint_as_float(rr[0]), __uint_as_float(rr[1])); }
__device__ __forceinline__ float half_sum(float m) { auto rr = __builtin_amdgcn_permlane32_swap(__float_as_uint(m), __float_as_uint(m), false, false); return __uint_as_float(rr[0]) + __uint_as_float(rr[1]); }

template <bool BIAS>
__device__ __forceinline__ void qk_tile(LAS unsigned char* Kb, const bf16x8 (&qr)[4], unsigned ka_off, int hi, f32x16& s0, f32x16& s1) {
    if (BIAS) {
#pragma unroll
        for (int j = 0; j < 4; ++j) { const f32x4 b0 = *(LAS f32x4*)(Kb + 8192 + (8 * j + 4 * hi) * 4), b1 = *(LAS f32x4*)(Kb + 8192 + 128 + (8 * j + 4 * hi) * 4);
#pragma unroll
            for (int i = 0; i < 4; ++i) { s0[4 * j + i] = b0[i]; s1[4 * j + i] = b1[i]; } }
    } else { s0 = f32x16{}; s1 = f32x16{}; }
#pragma unroll
    for (int s = 0; s < 4; ++s) {
        const bf16x8 k0 = *(LAS bf16x8*)(Kb + ka_off + s * 2048), k1 = *(LAS bf16x8*)(Kb + ka_off + s * 2048 + 512);
        s0 = __builtin_amdgcn_mfma_f32_32x32x16_bf16(k0, qr[s], s0, 0, 0, 0);
        s1 = __builtin_amdgcn_mfma_f32_32x32x16_bf16(k1, qr[s], s1, 0, 0, 0);
    }
}
__device__ __forceinline__ void mask_tile(f32x16& s0, f32x16& s1, int t, int qg, int hi) {
    const int kb = 64 * t + 4 * hi;
#pragma unroll
    for (int r = 0; r < 16; ++r) { const int kv = kb + (r & 3) + 8 * (r >> 2); if (kv > qg) s0[r] = -INFINITY; if (kv + 32 > qg) s1[r] = -INFINITY; }
}
__device__ __forceinline__ float rowmax32(const f32x16& s0, const f32x16& s1) {
    float a = fmaxf(fmaxf(s0[0], s0[1]), s1[0]), b = fmaxf(fmaxf(s0[2], s0[3]), s1[1]); a = fmaxf(fmaxf(a, s1[2]), s1[3]);
#pragma unroll
    for (int r = 4; r < 16; r += 4) { a = fmaxf(fmaxf(a, s0[r]), s0[r + 1]); b = fmaxf(fmaxf(b, s0[r + 2]), s0[r + 3]); a = fmaxf(fmaxf(a, s1[r]), s1[r + 1]); b = fmaxf(fmaxf(b, s1[r + 2]), s1[r + 3]); }
    return half_max(fmaxf(a, b));
}
template <int NV>
__device__ __forceinline__ void softmax_pv(LAS unsigned char* Vb, LAS float* wsf, f32x16& p0, f32x16& p1, float mx, float& m_run, float& l_run, f32x16 (&o)[NV][2], unsigned vb0, unsigned vb1, int r32, int hi) {
    const float m_new = fmaxf(m_run, mx);
    const float alpha = __builtin_amdgcn_exp2f(m_run - m_new);
    m_run = m_new;
    float ls = 0.f;
#pragma unroll
    for (int r = 0; r < 16; ++r) { p0[r] = __builtin_amdgcn_exp2f(p0[r] - m_new); p1[r] = __builtin_amdgcn_exp2f(p1[r] - m_new); ls += p0[r] + p1[r]; }
    l_run = l_run * alpha + ls;
    if (__any(alpha != 1.0f)) {
        if (hi == 0) wsf[r32] = alpha;
#pragma unroll
        for (int j = 0; j < 4; ++j) { const f32x4 a = *(LAS f32x4*)(wsf + 8 * j + 4 * hi);
#pragma unroll
            for (int nv = 0; nv < NV; ++nv)
#pragma unroll
                for (int d0 = 0; d0 < 2; ++d0)
#pragma unroll
                    for (int i = 0; i < 4; ++i) o[nv][d0][4 * j + i] *= a[i]; }
    }
    bf16x8 pa[4];
    { u32x4 w;
      w.x = pk_bf16(p0[0], p0[1]); w.y = pk_bf16(p0[2], p0[3]); w.z = pk_bf16(p0[4], p0[5]); w.w = pk_bf16(p0[6], p0[7]); pa[0] = __builtin_bit_cast(bf16x8, w);
      w.x = pk_bf16(p0[8], p0[9]); w.y = pk_bf16(p0[10], p0[11]); w.z = pk_bf16(p0[12], p0[13]); w.w = pk_bf16(p0[14], p0[15]); pa[1] = __builtin_bit_cast(bf16x8, w);
      w.x = pk_bf16(p1[0], p1[1]); w.y = pk_bf16(p1[2], p1[3]); w.z = pk_bf16(p1[4], p1[5]); w.w = pk_bf16(p1[6], p1[7]); pa[2] = __builtin_bit_cast(bf16x8, w);
      w.x = pk_bf16(p1[8], p1[9]); w.y = pk_bf16(p1[10], p1[11]); w.z = pk_bf16(p1[12], p1[13]); w.w = pk_bf16(p1[14], p1[15]); pa[3] = __builtin_bit_cast(bf16x8, w); }
#pragma unroll
    for (int nv = 0; nv < NV; ++nv)
#pragma unroll
        for (int d0 = 0; d0 < 2; ++d0) {
            LAS unsigned char* vp = Vb + nv * 8192 + (d0 ? vb1 : vb0);
#pragma unroll
            for (int s = 0; s < 4; ++s) {
                const s16x4 lo = tr_read(vp + s * 2048), hh = tr_read(vp + s * 2048 + 1024);
                const bf16x8 vf = {lo[0], lo[1], lo[2], lo[3], hh[0], hh[1], hh[2], hh[3]};
                o[nv][d0] = __builtin_amdgcn_mfma_f32_32x32x16_bf16(pa[s], vf, o[nv][d0], 0, 0, 0);
            }
        }
}

__device__ __forceinline__ void qk_load(LAS unsigned char* Kb, unsigned ka_off, bf16x8 (&kf)[8]) {
#pragma unroll
    for (int s = 0; s < 4; ++s) { kf[2 * s] = *(LAS bf16x8*)(Kb + ka_off + s * 2048); kf[2 * s + 1] = *(LAS bf16x8*)(Kb + ka_off + s * 2048 + 512); }
}
template <bool BIAS>
__device__ __forceinline__ void qk_mma(LAS unsigned char* Kb, const bf16x8 (&kf)[8], const bf16x8 (&qr)[4], int hi, f32x16& s0, f32x16& s1, const f32x16& cinit) {
    if (BIAS) {
#pragma unroll
        for (int j = 0; j < 4; ++j) { const f32x4 b0 = *(LAS f32x4*)(Kb + 8192 + (8 * j + 4 * hi) * 4), b1 = *(LAS f32x4*)(Kb + 8192 + 128 + (8 * j + 4 * hi) * 4);
#pragma unroll
            for (int i = 0; i < 4; ++i) { s0[4 * j + i] = b0[i]; s1[4 * j + i] = b1[i]; } }
    }
    if (BIAS) {
#pragma unroll
        for (int s = 0; s < 4; ++s) {
            s0 = __builtin_amdgcn_mfma_f32_32x32x16_bf16(kf[2 * s], qr[s], s0, 0, 0, 0);
            s1 = __builtin_amdgcn_mfma_f32_32x32x16_bf16(kf[2 * s + 1], qr[s], s1, 0, 0, 0);
        }
    } else {
        s0 = __builtin_amdgcn_mfma_f32_32x32x16_bf16(kf[0], qr[0], cinit, 0, 0, 0);
        s1 = __builtin_amdgcn_mfma_f32_32x32x16_bf16(kf[1], qr[0], cinit, 0, 0, 0);
#pragma unroll
        for (int s = 1; s < 4; ++s) {
            s0 = __builtin_amdgcn_mfma_f32_32x32x16_bf16(kf[2 * s], qr[s], s0, 0, 0, 0);
            s1 = __builtin_amdgcn_mfma_f32_32x32x16_bf16(kf[2 * s + 1], qr[s], s1, 0, 0, 0);
        }
    }
}
__device__ __forceinline__ void v_load(LAS unsigned char* vp, s16x4 (&v)[8]) {
#pragma unroll
    for (int s = 0; s < 4; ++s) { v[2 * s] = tr_read(vp + s * 2048); v[2 * s + 1] = tr_read(vp + s * 2048 + 1024); }
}
__device__ __forceinline__ void pv_mma(const bf16x8 (&pa)[4], const s16x4 (&v)[8], f32x16& oo) {
#pragma unroll
    for (int s = 0; s < 4; ++s) { const bf16x8 vf = {v[2 * s][0], v[2 * s][1], v[2 * s][2], v[2 * s][3], v[2 * s + 1][0], v[2 * s + 1][1], v[2 * s + 1][2], v[2 * s + 1][3]};
        oo = __builtin_amdgcn_mfma_f32_32x32x16_bf16(pa[s], vf, oo, 0, 0, 0); }
}
template <int NV>
__device__ __forceinline__ void softmax_pv3(LAS unsigned char* Vb, LAS float* wsf, f32x16& p0, f32x16& p1, float mx, float& m_run, float& l_run, f32x16 (&o)[NV][2], s16x4 (&va)[8], s16x4 (&vb)[8], unsigned vb0, unsigned vb1, int r32, int hi) {
    const float m_new = fmaxf(m_run, mx);
    const float alpha = __builtin_amdgcn_exp2f(m_run - m_new);
    m_run = m_new;
    if (__any(alpha != 1.0f)) {
        if (hi == 0) wsf[r32] = alpha;
#pragma unroll
        for (int j = 0; j < 4; ++j) { const f32x4 a = *(LAS f32x4*)(wsf + 8 * j + 4 * hi);
#pragma unroll
            for (int nv = 0; nv < NV; ++nv)
#pragma unroll
                for (int d0 = 0; d0 < 2; ++d0)
#pragma unroll
                    for (int i = 0; i < 4; ++i) o[nv][d0][4 * j + i] *= a[i]; }
    }
    float ls = 0.f;
#pragma unroll
    for (int r = 0; r < 16; ++r) { p0[r] = __builtin_amdgcn_exp2f(p0[r] - m_new); p1[r] = __builtin_amdgcn_exp2f(p1[r] - m_new); ls += p0[r] + p1[r]; }
    l_run = l_run * alpha + ls;
    bf16x8 pa[4];
    { u32x4 w;
      w.x = pk_bf16(p0[0], p0[1]); w.y = pk_bf16(p0[2], p0[3]); w.z = pk_bf16(p0[4], p0[5]); w.w = pk_bf16(p0[6], p0[7]); pa[0] = __builtin_bit_cast(bf16x8, w);
      w.x = pk_bf16(p0[8], p0[9]); w.y = pk_bf16(p0[10], p0[11]); w.z = pk_bf16(p0[12], p0[13]); w.w = pk_bf16(p0[14], p0[15]); pa[1] = __builtin_bit_cast(bf16x8, w);
      w.x = pk_bf16(p1[0], p1[1]); w.y = pk_bf16(p1[2], p1[3]); w.z = pk_bf16(p1[4], p1[5]); w.w = pk_bf16(p1[6], p1[7]); pa[2] = __builtin_bit_cast(bf16x8, w);
      w.x = pk_bf16(p1[8], p1[9]); w.y = pk_bf16(p1[10], p1[11]); w.z = pk_bf16(p1[12], p1[13]); w.w = pk_bf16(p1[14], p1[15]); pa[3] = __builtin_bit_cast(bf16x8, w); }
    pv_mma(pa, va, o[0][0]);
    if (NV == 2) { v_load(Vb + 8192 + vb0, va); __builtin_amdgcn_sched_barrier(0); }
    pv_mma(pa, vb, o[0][1]);
    if (NV == 2) {
        v_load(Vb + 8192 + vb1, vb); __builtin_amdgcn_sched_barrier(0);
        pv_mma(pa, va, o[NV - 1][0]);
        pv_mma(pa, vb, o[NV - 1][1]);
    }
}

template <int NV>
__device__ __forceinline__ void v_load_ks(LAS unsigned char* Vb, unsigned vb0, unsigned vb1, int s, s16x4 (&v)[4 * NV]) {
#pragma unroll
    for (int g = 0; g < 2 * NV; ++g) { LAS unsigned char* vp = Vb + (g >> 1) * 8192 + ((g & 1) ? vb1 : vb0) + s * 2048; v[2 * g] = tr_read(vp); v[2 * g + 1] = tr_read(vp + 1024); }
}
template <int NV>
__device__ __forceinline__ void softmax_pv4(LAS unsigned char* Vb, LAS float* wsf, f32x16& p0, f32x16& p1, float mx, float& m_run, float& l_run, f32x16 (&o)[NV][2], s16x4 (&va)[4 * NV], unsigned vb0, unsigned vb1, int r32, int hi, f32x16& negm, bool& started, LAS unsigned char* Kb, unsigned ka_off, bf16x8 (&kf)[8], const bool do_next) {
    constexpr bool LAZY = (NV == 2);
    float m_new, alpha;
    if constexpr (LAZY) {
        const bool first = !started;
        if (first || __any(mx > 8.0f)) {
            const float dl = first ? mx : fmaxf(mx, 0.f);
            m_run += dl;
#pragma unroll
            for (int r = 0; r < 16; ++r) { p0[r] -= dl; p1[r] -= dl; }
#pragma unroll
            for (int r = 0; r < 16; ++r) negm[r] = -m_run;
            alpha = first ? 1.0f : __builtin_amdgcn_exp2f(-dl);
            l_run *= alpha;
        } else alpha = 1.0f;
        started = true; m_new = 0.f;
    } else {
        m_new = fmaxf(m_run, mx);
        alpha = __builtin_amdgcn_exp2f(m_run - m_new);
        m_run = m_new;
    }
    if (__any(alpha != 1.0f)) {
        if (hi == 0) wsf[r32] = alpha;
#pragma unroll
        for (int j = 0; j < 4; ++j) { const f32x4 a = *(LAS f32x4*)(wsf + 8 * j + 4 * hi);
#pragma unroll
            for (int nv = 0; nv < NV; ++nv)
#pragma unroll
                for (int d0 = 0; d0 < 2; ++d0)
#pragma unroll
                    for (int i = 0; i < 4; ++i) o[nv][d0][4 * j + i] *= a[i]; }
    }
    typedef float f32x2v __attribute__((ext_vector_type(2)));
    f32x2v ls2_ = {0.f, 0.f}; const f32x2v m2_ = {m_new, m_new};
    s16x4 vbb[4 * NV];
    u32x4 w0, w1, w2, w3;
#define PV4_E2(P, B, W, C) do { const f32x2v t_ = (f32x2v){P[B], P[B + 1]} - m2_; const f32x2v e_ = {__builtin_amdgcn_exp2f(t_.x), __builtin_amdgcn_exp2f(t_.y)}; ls2_ += e_; W[C] = pk_bf16(e_.x, e_.y); } while (0)
#define PV4_MF(W, V, G) do { const bf16x8 vf_ = {V[2 * (G)][0], V[2 * (G)][1], V[2 * (G)][2], V[2 * (G)][3], V[2 * (G) + 1][0], V[2 * (G) + 1][1], V[2 * (G) + 1][2], V[2 * (G) + 1][3]}; \
        o[(G) >> 1][(G) & 1] = __builtin_amdgcn_mfma_f32_32x32x16_bf16(__builtin_bit_cast(bf16x8, W), vf_, o[(G) >> 1][(G) & 1], 0, 0, 0); } while (0)
#define SB() __builtin_amdgcn_sched_barrier(0)
#define PV4_TR(S, G, DST) do { LAS unsigned char* vp_ = Vb + ((G) >> 1) * 8192 + (((G) & 1) ? vb1 : vb0) + (S) * 2048; DST[2 * (G)] = tr_read(vp_); DST[2 * (G) + 1] = tr_read(vp_ + 1024); } while (0)
#define PV4_KL(G) do { if (do_next) { kf[2 * (G)] = *(LAS bf16x8*)(Kb + ka_off + (G) * 2048); kf[2 * (G) + 1] = *(LAS bf16x8*)(Kb + ka_off + (G) * 2048 + 512); } } while (0)
    PV4_E2(p0, 0, w0, 0); PV4_E2(p0, 2, w0, 1); PV4_E2(p0, 4, w0, 2); PV4_E2(p0, 6, w0, 3); SB();
    if (NV == 2) {
        PV4_MF(w0, va, 0); PV4_TR(1, 0, vbb); PV4_E2(p0, 8, w1, 0); SB(); PV4_MF(w0, va, 1); PV4_TR(1, 1, vbb); PV4_E2(p0, 10, w1, 1); SB();
        PV4_MF(w0, va, 2); PV4_TR(1, 2, vbb); PV4_E2(p0, 12, w1, 2); SB(); PV4_MF(w0, va, 3); PV4_TR(1, 3, vbb); PV4_E2(p0, 14, w1, 3); SB();
        PV4_MF(w1, vbb, 0); PV4_TR(2, 0, va); PV4_E2(p1, 0, w2, 0); SB(); PV4_MF(w1, vbb, 1); PV4_TR(2, 1, va); PV4_E2(p1, 2, w2, 1); SB();
        PV4_MF(w1, vbb, 2); PV4_TR(2, 2, va); PV4_E2(p1, 4, w2, 2); SB(); PV4_MF(w1, vbb, 3); PV4_TR(2, 3, va); PV4_E2(p1, 6, w2, 3); SB();
        PV4_MF(w2, va, 0); PV4_TR(3, 0, vbb); PV4_E2(p1, 8, w3, 0); SB(); PV4_MF(w2, va, 1); PV4_TR(3, 1, vbb); PV4_E2(p1, 10, w3, 1); SB();
        PV4_MF(w2, va, 2); PV4_TR(3, 2, vbb); PV4_E2(p1, 12, w3, 2); SB(); PV4_MF(w2, va, 3); PV4_TR(3, 3, vbb); PV4_E2(p1, 14, w3, 3); SB();
        PV4_MF(w3, vbb, 0); PV4_KL(0); SB(); PV4_MF(w3, vbb, 1); PV4_KL(1); SB(); PV4_MF(w3, vbb, 2); PV4_KL(2); SB(); PV4_MF(w3, vbb, 3); PV4_KL(3); SB();
    } else {
        PV4_MF(w0, va, 0); PV4_TR(1, 0, vbb); PV4_E2(p0, 8, w1, 0); PV4_E2(p0, 10, w1, 1); SB(); PV4_MF(w0, va, 1); PV4_TR(1, 1, vbb); PV4_E2(p0, 12, w1, 2); PV4_E2(p0, 14, w1, 3); SB();
        PV4_MF(w1, vbb, 0); PV4_TR(2, 0, va); PV4_E2(p1, 0, w2, 0); PV4_E2(p1, 2, w2, 1); SB(); PV4_MF(w1, vbb, 1); PV4_TR(2, 1, va); PV4_E2(p1, 4, w2, 2); PV4_E2(p1, 6, w2, 3); SB();
        PV4_MF(w2, va, 0); PV4_TR(3, 0, vbb); PV4_E2(p1, 8, w3, 0); PV4_E2(p1, 10, w3, 1); SB(); PV4_MF(w2, va, 1); PV4_TR(3, 1, vbb); PV4_E2(p1, 12, w3, 2); PV4_E2(p1, 14, w3, 3); SB();
        PV4_MF(w3, vbb, 0); PV4_KL(0); PV4_KL(1); SB(); PV4_MF(w3, vbb, 1); PV4_KL(2); PV4_KL(3); SB();
    }
#undef PV4_TR
#undef PV4_KL
#undef PV4_E2
#undef PV4_MF
#undef SB
    l_run = (LAZY ? l_run : l_run * alpha) + (ls2_.x + ls2_.y);
}

template <int NV, bool BIAS>
__device__ __forceinline__ void attn_pass(LAS unsigned char* L, const bf16_t* __restrict__ Qp, const bf16_t* __restrict__ Kp, const bf16_t* __restrict__ Vp0, const bf16_t* __restrict__ Vp1,
                                          const float* __restrict__ cbp, int qb, f32x16 (&o)[NV][2], const int tid, const float* __restrict__ kn2p, const float gk) {
    const int lane = tid & 63, r32 = lane & 31, hi = lane >> 5;
    const int wid = __builtin_amdgcn_readfirstlane(tid >> 6);
    const int q0w = qb * 256 + wid * 32, qg = q0w + r32;
    const int NT = 4 * qb + 4, T0 = NT - 1, tmax = 4 * qb + (wid >> 1);
    bf16x8 qr[4];
#pragma unroll
    for (int s = 0; s < 4; ++s) qr[s] = *(const bf16x8*)(Qp + (size_t)(q0w + r32) * 64 + 16 * s + 8 * hi);
    int NS = NT;
    if (BIAS) {
        LAS unsigned* mw = (LAS unsigned*)(L + A_MISC);
        float q2 = 0.f;
#pragma unroll
        for (int s = 0; s < 4; ++s)
#pragma unroll
            for (int j = 0; j < 8; ++j) { const float v = __uint_as_float(((unsigned)(unsigned short)qr[s][j]) << 16); q2 += v * v; }
        const float qn = sqrtf(half_sum(q2)) * 1.02f;
        float val = cbp[qg] - qn * (gk + sqrtf(kn2p[qg]) * 1.02f) - 170.0f;
        val = fminf(val, __shfl_xor(val, 1)); val = fminf(val, __shfl_xor(val, 2)); val = fminf(val, __shfl_xor(val, 4)); val = fminf(val, __shfl_xor(val, 8)); val = fminf(val, __shfl_xor(val, 16));
        if (tid == 0) mw[2] = 0u;
        if (lane == 0) ((LAS float*)mw)[4 + wid] = val;
        __syncthreads();
        float thr = ((LAS float*)mw)[4];
#pragma unroll
        for (int w = 1; w < 8; ++w) thr = fminf(thr, ((LAS float*)mw)[4 + w]);
        if (gk >= 0.f && tid < NT && cbp[64 * tid + 63] < thr) __hip_atomic_fetch_max(mw + 2, (unsigned)(tid + 1), __ATOMIC_RELAXED, __HIP_MEMORY_SCOPE_WORKGROUP);
        __syncthreads();
        int t_stop = (int)mw[2];
        if ((NT - t_stop) & 1) t_stop -= 1;
        NS = NT - t_stop;
    }
    const int kvr = tid >> 3, chv = tid & 7;
    const bf16_t* kg = Kp + (size_t)lane * 64 + wid * 8;
    const int vxo = kvr * 64 + ((chv ^ (((kvr >> 1) & 1) << 2)) << 3);
    const bf16_t* vgx0 = Vp0 + vxo;
    const bf16_t* vgx1 = Vp1 + vxo;
    const unsigned ka_off = hi * 1024 + r32 * 16;
    const int g1 = (lane >> 4) & 1, qq = (lane & 15) >> 2, pp = lane & 3, xq = (qq >> 1) & 1;
    const unsigned vrow = (4 * hi + qq) * 128 + 32 * g1 + 8 * pp;
    const unsigned vb0 = vrow + (xq ? 64 : 0), vb1 = vrow + (xq ? 0 : 64);
    LAS float* wsf = (LAS float*)(L + A_WSF + wid * 128);
    f32x4 bst = {0.f, 0.f, 0.f, 0.f};
    float m_run = (NV == 2) ? 0.f : -1e30f, l_run = 0.f; f32x16 negm = f32x16{}; bool started = false;
#pragma unroll
    for (int nv = 0; nv < NV; ++nv) { o[nv][0] = f32x16{}; o[nv][1] = f32x16{}; }
#define ATT_LOADK(tt) do { __builtin_amdgcn_global_load_lds((const unsigned*)(kg + (size_t)(tt) * 4096), (LAS unsigned*)(L + kdst_ * A_KB + wid * 1024), 16, 0, 0); \
        if (BIAS && tid < 16) bst = *(const f32x4*)(cbp + (tt) * 64 + tid * 4); } while (0)
#define ATT_LOADV(tt) do { __builtin_amdgcn_global_load_lds((const unsigned*)(vgx0 + (size_t)(tt) * 4096), (LAS unsigned*)(L + A_VBASE + vdst_ * A_VB + wid * 1024), 16, 0, 0); \
        if (NV == 2) __builtin_amdgcn_global_load_lds((const unsigned*)(vgx1 + (size_t)(tt) * 4096), (LAS unsigned*)(L + A_VBASE + vdst_ * A_VB + 8192 + wid * 1024), 16, 0, 0); } while (0)
#define ATT_STOREK(b) do { if (BIAS && tid < 16) *(LAS f32x4*)(L + (b) * A_KB + 8192 + tid * 16) = bst; } while (0)
#define ATT_STOREV(b) do { } while (0)
    int kdst_ = 0, vdst_ = 0;
    kdst_ = 0; vdst_ = 0; ATT_LOADK(T0); ATT_LOADV(T0); ATT_STOREK(0);
    kdst_ = 1; ATT_LOADK(T0 - 1); ATT_STOREK(1);
    __syncthreads();
    f32x16 s0, s1;
    if (T0 <= tmax) { qk_tile<BIAS>(L, qr, ka_off, hi, s0, s1); mask_tile(s0, s1, T0, qg, hi); }
    __syncthreads();
    bf16x8 kf[8]; s16x4 va[4 * NV];
#define ATT_STEP(i) do { \
        const int t_ = T0 - (i); const int kb_ = ((i) + 1) & 1, vbuf_ = (i) & 1; \
        { const int tk_ = t_ - 2 > 0 ? t_ - 2 : 0, tv_ = t_ - 1 > 0 ? t_ - 1 : 0; kdst_ = vbuf_; vdst_ = kb_; ATT_LOADK(tk_); ATT_LOADV(tv_); } \
        LAS unsigned char* Kb_ = L + kb_ * A_KB; LAS unsigned char* Vb_ = L + A_VBASE + vbuf_ * A_VB; \
        const bool do_next_ = (t_ >= 1) && (t_ - 1 <= tmax); \
        bool do_cur_ = (t_ <= tmax); float mxc_ = 0.f; \
        if (do_cur_) { v_load_ks<NV>(Vb_, vb0, vb1, 0, va); __builtin_amdgcn_sched_barrier(0); \
                       mxc_ = rowmax32(s0, s1); if (BIAS) do_cur_ = __any(mxc_ >= m_run - 160.0f) != 0; } \
        if (do_next_ && NV == 1 && !do_cur_) { qk_load(Kb_, ka_off, kf); __builtin_amdgcn_sched_barrier(0); } \
        if (do_cur_) softmax_pv4<NV>(Vb_, wsf, s0, s1, mxc_, m_run, l_run, o, va, vb0, vb1, r32, hi, negm, started, Kb_, ka_off, kf, NV == 1 && do_next_); \
        if (do_next_) { if (NV == 2) qk_load(Kb_, ka_off, kf); qk_mma<BIAS>(Kb_, kf, qr, hi, s0, s1, negm); if (64 * (t_ - 1) + 63 > q0w) mask_tile(s0, s1, t_ - 1, qg, hi); } \
        ATT_STOREK(vbuf_); ATT_STOREV(kb_); \
        __syncthreads(); } while (0)
    for (int i = 0; i < NS; i += 2) { ATT_STEP(i); ATT_STEP(i + 1); }
#undef ATT_STEP
#undef ATT_LOADK
#undef ATT_LOADV
#undef ATT_STOREK
#undef ATT_STOREV
    const float inv = 1.0f / half_sum(l_run);
    if (hi == 0) wsf[r32] = inv;
#pragma unroll
    for (int j = 0; j < 4; ++j) { const f32x4 a = *(LAS f32x4*)(wsf + 8 * j + 4 * hi);
#pragma unroll
        for (int nv = 0; nv < NV; ++nv)
#pragma unroll
            for (int d0 = 0; d0 < 2; ++d0)
#pragma unroll
                for (int i = 0; i < 4; ++i) o[nv][d0][4 * j + i] *= a[i]; }
}

struct AttnArgs { const bf16_t* qkv; const float* cb; const bf16_t* z; bf16_t* y; float* park; const float* kn2; unsigned* counter; const float* gsub; float lam; };

__device__ __forceinline__ int lane_now() { int l; asm volatile("v_mbcnt_lo_u32_b32 %0, -1, 0\n\tv_mbcnt_hi_u32_b32 %0, -1, %0" : "=v"(l)); return l; }
__device__ __forceinline__ float xlane(float v, int src_lane) { return __int_as_float(__builtin_amdgcn_ds_bpermute(src_lane << 2, __float_as_int(v))); }
__device__ __forceinline__ void attn_phase(LAS unsigned char* L, const AttnArgs& A, const int wv  ) {
    LAS unsigned* misc = (LAS unsigned*)(L + A_MISC);
    const int xcd = blockIdx.x & 7;
    {
        const int w0 = wv, l0 = lane_now(); const float* kp = A.kn2 + (size_t)(xcd * 8 + w0) * SEQ; float mx = 0.f;
        for (int i = l0; i < SEQ; i += 64) mx = fmaxf(mx, kp[i]);
#pragma unroll
        for (int o = 1; o < 64; o <<= 1) mx = fmaxf(mx, __shfl_xor(mx, o));
        if (l0 == 0) ((LAS float*)misc)[16 + w0] = sqrtf(mx) * 1.02f;
    }
    for (int kq = 0; kq < 8; ++kq) {
    const int qx = (xcd + kq) & 7;
    for (;;) {
        __syncthreads();
        if (wv == 0 && lane_now() == 0) misc[0] = atomicAdd(A.counter + 32 * qx, 1u);
        __syncthreads();
        const unsigned idx = misc[0];
        if (idx >= 384u) break;
        const int slot = idx >> 5; const int qb = 31 - (int)(idx & 31u);
        const unsigned code = slot < 4 ? 2048u + (unsigned)((qx * 4 + slot) * 32 + qb) : (unsigned)((qx * 8 + (slot - 4)) * 32 + qb);
        const int wid = wv;
        const int q0w = qb * 256 + wid * 32;
#ifndef ATT_TEST
#define ATT_TEST 3
#endif
        if ((ATT_TEST & 1) && code < 2048u) {
            const int tid = wv * 64 + lane_now();
            const int bh = code >> 5, b = bh >> 3, h = bh & 7;
            const size_t so = (size_t)bh * SEQ * 64;
            f32x16 o[1][2];
            const float gkv = (b == xcd) ? ((LAS float*)misc)[16 + h] : -1.0f;
            attn_pass<1, true>(L, A.qkv + so, A.qkv + SB + so, A.qkv + 2 * SB + so, nullptr, A.cb + (size_t)bh * SEQ, qb, o, tid, A.kn2 + (size_t)bh * SEQ, gkv);
            const int lane1 = lane_now();
            size_t ebase = (size_t)(b * SEQ + q0w + 4 * (lane1 >> 5)) * 512 + h * 64 + (lane1 & 31); asm volatile("" : "+v"(ebase));
            bf16_t* ya = A.y + ebase; const bf16_t* za = A.z + ebase;
#pragma unroll
            for (int d0 = 0; d0 < 2; ++d0) {
#pragma unroll
                for (int r = 0; r < 16; ++r) { const int e = ((r & 3) + 8 * (r >> 2)) * 512 + 32 * d0;
                    ya[e] = bf16_1(o[0][d0][r] * bf1(za[e])); }
                asm volatile("" ::: "memory"); }
        } else if (ATT_TEST & 2) {
            const int tid = wv * 64 + lane_now();
            const int bhd = (code - 2048u) >> 5, b = bhd >> 2, hd = bhd & 3;
            const size_t s0 = (size_t)(b * 8 + hd * 2) * SEQ * 64, s1 = s0 + (size_t)SEQ * 64;
            float* pk = A.park + (size_t)blockIdx.x * 32768 + tid * 64;
            f32x16 o[2][2];
            attn_pass<2, false>(L, A.qkv + 3 * SB + s0, A.qkv + 4 * SB + s0, A.qkv + 5 * SB + s0, A.qkv + 5 * SB + s1, nullptr, qb, o, tid, nullptr, -1.0f);
            { float* pk1 = pk; asm volatile("" : "+v"(pk1));
#pragma unroll
            for (int nv = 0; nv < 2; ++nv)
#pragma unroll
                for (int d0 = 0; d0 < 2; ++d0)
#pragma unroll
                    for (int j = 0; j < 4; ++j) { const f32x4 w = {o[nv][d0][4 * j], o[nv][d0][4 * j + 1], o[nv][d0][4 * j + 2], o[nv][d0][4 * j + 3]}; *(f32x4*)(pk1 + (nv * 2 + d0) * 16 + 4 * j) = w; }
            asm volatile("" ::: "memory"); }
            const int tid2_ = wv * 64 + lane_now();
            attn_pass<2, false>(L, A.qkv + 3 * SB + s1, A.qkv + 4 * SB + s1, A.qkv + 5 * SB + s0, A.qkv + 5 * SB + s1, nullptr, qb, o, tid2_, nullptr, -1.0f);
            f32x16 ss = f32x16{};
            const int lane2 = lane_now(), r32e = lane2 & 31, hie = lane2 >> 5;
            const float* pk2 = pk; asm volatile("" : "+v"(pk2));
#pragma unroll
            for (int nv = 0; nv < 2; ++nv)
#pragma unroll
                for (int d0 = 0; d0 < 2; ++d0) {
#pragma unroll
                    for (int j = 0; j < 4; ++j) { const f32x4 w = *(const f32x4*)(pk2 + (nv * 2 + d0) * 16 + 4 * j);
#pragma unroll
                        for (int i = 0; i < 4; ++i) { const int r = 4 * j + i; const float v = w[i] - A.lam * o[nv][d0][r]; o[nv][d0][r] = v; ss[r] += v * v; } }
                    asm volatile("" ::: "memory");
                }
#pragma unroll
            for (int r = 0; r < 16; ++r) { float s = ss[r]; s += xlane(s, lane2 ^ 1); s += xlane(s, lane2 ^ 2); s += xlane(s, lane2 ^ 4); s += xlane(s, lane2 ^ 8); s += xlane(s, lane2 ^ 16);
                ss[r] = 0.8f * __builtin_amdgcn_rsqf(s * (1.0f / 128.0f) + 1e-5f); }
            size_t ebase = (size_t)(b * SEQ + q0w + 4 * hie) * 512 + hd * 128 + r32e; asm volatile("" : "+v"(ebase));
            bf16_t* yb = A.y + (size_t)M * 512 + ebase; const bf16_t* zb = A.z + (size_t)M * 512 + ebase;
#pragma unroll
            for (int nv = 0; nv < 2; ++nv)
#pragma unroll
                for (int d0 = 0; d0 < 2; ++d0) { const int d = 64 * nv + 32 * d0; const float gs = A.gsub[d + r32e];
#pragma unroll
                    for (int r = 0; r < 16; ++r) { const int e = ((r & 3) + 8 * (r >> 2)) * 512 + d;
                        yb[e] = bf16_1(o[nv][d0][r] * ss[r] * gs * bf1(zb[e])); }
                    asm volatile("" ::: "memory"); }
        }
    }
    }
}

__device__ __forceinline__ int col_src(int n) {
    if (n >= 4096) return 4104 + (n - 4096);
    const int seg = n >> 9, c = n & 511;
    if (seg == 4 || seg == 5) { const int uu = c >> 6, p = c & 63, a = p >> 3, bb = p & 7; const int dim = bb < 4 ? 4 * a + bb : 32 + 4 * a + (bb - 4); return (seg == 4 ? 2056 : 2568) + uu * 64 + dim; }
    const int base = seg == 0 ? 0 : seg == 1 ? 512 : seg == 2 ? 1024 : seg == 3 ? 1544 : seg == 6 ? 3080 : 3592;
    return base + c;
}
template <bool MAP>
__device__ __forceinline__ void transpose_tile(LAS unsigned char* L, const float* __restrict__ src, int ld, int K, bf16_t* __restrict__ dst, int n0, int k0) {
    LAS float* ts = (LAS float*)L;
    const int tid = threadIdx.x, a = tid >> 6, c = tid & 63;
    const int sc = MAP ? col_src(n0 + c) : (n0 + c);
    float v[8];
#pragma unroll
    for (int p = 0; p < 8; ++p) v[p] = src[(size_t)(k0 + p * 8 + a) * ld + sc];
    __syncthreads();
#pragma unroll
    for (int p = 0; p < 8; ++p) ts[(p * 8 + a) * 65 + c] = v[p];
    __syncthreads();
#pragma unroll
    for (int p = 0; p < 8; ++p) { const int n = p * 8 + a; dst[(size_t)(n0 + n) * K + k0 + c] = bf16_1(ts[c * 65 + n]); }
}

struct P { const float* x; const float* g_pre; const float* w_in; const float* b_forget; const float* lq1; const float* lk1; const float* lq2; const float* lk2;
           const float* g_subln; const float* w_branch; const float* w_out; const float* g_post; float* out; unsigned char* ws; };

__device__ __forceinline__ void p0_prologue(LAS unsigned char* L, const P& p) {
    const int tid = threadIdx.x, lane = tid & 63, wid = tid >> 6;
    const int gtid = blockIdx.x * 512 + tid, gsz = gridDim.x * 512;
    unsigned char* ws = p.ws;
    float* ssq = (float*)(ws + WS_SSQ);
    for (int i = gtid; i < M; i += gsz) ssq[i] = 0.f;
    { float* kn2 = (float*)(ws + WS_KN2); for (int i = gtid; i < 64 * SEQ; i += gsz) kn2[i] = 0.f; }
    if (gtid < 8) ((unsigned*)(ws + WS_CTL))[32 * gtid] = 0u;
    if (gtid == 0) {
        float d1 = 0.f, d2 = 0.f;
        for (int i = 0; i < 64; ++i) { d1 += p.lq1[i] * p.lk1[i]; d2 += p.lq2[i] * p.lk2[i]; }
        ((float*)(ws + WS_CTL))[512] = expf(d1) - expf(d2) + 0.2f; }
    if (gtid < NITEMS) {
        unsigned* items = (unsigned*)(ws + WS_ITEMS); int rank; unsigned code;
        if (gtid < 1024) { const int qb = gtid >> 5, j = gtid & 31, c = 3 * (qb + 1); rank = 32 * (31 - qb) + 64 * (32 - c > 0 ? 32 - c : 0) + j; code = 2048u + (unsigned)(j * 32 + qb); }
        else { const int i2 = gtid - 1024, qb = i2 >> 6, j = i2 & 63, c = qb + 1; rank = 32 * (33 - (c + 2) / 3) + 64 * (32 - c) + j; code = (unsigned)(j * 32 + qb); }
        items[rank] = code;
    }
    {
        float* cs = (float*)(ws + WS_COS); float* sn = (float*)(ws + WS_SIN);
        for (int i = gtid; i < SEQ * 32; i += gsz) { const int s = i >> 5, f = i & 31;
            const double invf = exp2(-(double)f * (13.287712379549449 / 32.0));
            double rev = (double)s * invf * 0.15915494309189535; rev -= floor(rev);
            const float rf = (float)rev; cs[i] = __builtin_amdgcn_cosf(rf); sn[i] = __builtin_amdgcn_sinf(rf); }
    }
    for (int tt = blockIdx.x; tt < 2048; tt += gridDim.x) {
        if (tt < 1536) transpose_tile<true>(L, p.w_in, NIN, DM, (bf16_t*)(ws + WS_BT1), (tt >> 4) << 6, (tt & 15) << 6);
        else if (tt < 1792) { const int u = tt - 1536, br = u >> 7, v = u & 127;
            transpose_tile<false>(L, p.w_branch + (size_t)br * 512 * DM, DM, 512, (bf16_t*)(ws + WS_BT3A) + (size_t)br * DM * 512, (v >> 3) << 6, (v & 7) << 6); }
        else { const int u = tt - 1792; transpose_tile<false>(L, p.w_out, DM, DM, (bf16_t*)(ws + WS_BT3B), (u >> 4) << 6, (u & 15) << 6); }
    }
    {
        f32x4 gp[4]; float wf[4][4][8];
#pragma unroll
        for (int j = 0; j < 4; ++j) { gp[j] = *(const f32x4*)(p.g_pre + 4 * lane + 256 * j);
#pragma unroll
            for (int i = 0; i < 4; ++i) { const float* wp = p.w_in + (size_t)(4 * lane + 256 * j + i) * NIN + 1536; const f32x4 w0 = *(const f32x4*)wp, w1 = *(const f32x4*)(wp + 4);
                wf[j][i][0] = w0[0]; wf[j][i][1] = w0[1]; wf[j][i][2] = w0[2]; wf[j][i][3] = w0[3]; wf[j][i][4] = w1[0]; wf[j][i][5] = w1[1]; wf[j][i][6] = w1[2]; wf[j][i][7] = w1[3]; } }
        const int hh = (lane & 1) * 4 + ((lane >> 1) & 1) * 2 + ((lane >> 2) & 1);
        const float bfg = p.b_forget[hh];
        bf16_t* hb = (bf16_t*)(ws + WS_H); float* logf_ = (float*)(ws + WS_LOGF);
        const int rstep = gridDim.x * 8;
        int row = blockIdx.x * 8 + wid;
        f32x4 xv[4], xm[4], xn[4];
#pragma unroll
        for (int j = 0; j < 4; ++j) xv[j] = __builtin_nontemporal_load((const f32x4*)(p.x + (size_t)row * DM + 4 * lane + 256 * j));
        { const int r1 = row + rstep < M ? row + rstep : row;
#pragma unroll
          for (int j = 0; j < 4; ++j) xm[j] = __builtin_nontemporal_load((const f32x4*)(p.x + (size_t)r1 * DM + 4 * lane + 256 * j)); }
        for (; row < M; row += rstep) {
            const int rnext = row + 2 * rstep < M ? row + 2 * rstep : row;
#pragma unroll
            for (int j = 0; j < 4; ++j) xn[j] = __builtin_nontemporal_load((const f32x4*)(p.x + (size_t)rnext * DM + 4 * lane + 256 * j));
            float ss = 0.f;
#pragma unroll
            for (int j = 0; j < 4; ++j) ss += (xv[j][0] * xv[j][0] + xv[j][1] * xv[j][1]) + (xv[j][2] * xv[j][2] + xv[j][3] * xv[j][3]);
#pragma unroll
            for (int o = 1; o < 64; o <<= 1) ss += __shfl_xor(ss, o);
            const float rs = 1.0f / sqrtf(ss * (1.0f / 1024.0f) + 1e-6f);
            float fa[8] = {0.f, 0.f, 0.f, 0.f, 0.f, 0.f, 0.f, 0.f};
#pragma unroll
            for (int j = 0; j < 4; ++j) { const f32x4 hv = xv[j] * rs * gp[j];
                u32x2 w; w.x = pk_bf16(hv[0], hv[1]); w.y = pk_bf16(hv[2], hv[3]); *(u32x2*)(hb + (size_t)row * DM + 4 * lane + 256 * j) = w;
#pragma unroll
                for (int i = 0; i < 4; ++i)
#pragma unroll
                    for (int e = 0; e < 8; ++e) fa[e] += hv[i] * wf[j][i][e]; }
            float g4[4], g2[2], g1;
            { const bool up = (lane & 1) != 0;
#pragma unroll
              for (int k = 0; k < 4; ++k) { const float snd = up ? fa[k] : fa[k + 4]; const float rcv = __shfl_xor(snd, 1); g4[k] = (up ? fa[k + 4] : fa[k]) + rcv; } }
            { const bool up = (lane & 2) != 0;
#pragma unroll
              for (int k = 0; k < 2; ++k) { const float snd = up ? g4[k] : g4[k + 2]; const float rcv = __shfl_xor(snd, 2); g2[k] = (up ? g4[k + 2] : g4[k]) + rcv; } }
            { const bool up = (lane & 4) != 0; const float snd = up ? g2[0] : g2[1]; const float rcv = __shfl_xor(snd, 4); g1 = (up ? g2[1] : g2[0]) + rcv; }
            g1 += __shfl_xor(g1, 8); g1 += __shfl_xor(g1, 16); g1 += __shfl_xor(g1, 32);
            if (lane < 8) { const float zf = g1 + bfg; const float ls = fminf(zf, 0.f) - log1pf(expf(-fabsf(zf)));
                logf_[(size_t)((row >> 13) * 8 + hh) * SEQ + (row & (SEQ - 1))] = ls; }
#pragma unroll
            for (int j = 0; j < 4; ++j) { xv[j] = xm[j]; xm[j] = xn[j]; }
        }
    }
}

__device__ __forceinline__ void cumsum_seq(LAS unsigned char* L, const float* __restrict__ lf, float* __restrict__ cb, const int wv) {
    const int lane = lane_now(), wid = wv, tid = wv * 64 + lane;
    LAS float* wt = (LAS float*)L;
    f32x4 v[4]; float run = 0.f;
#pragma unroll
    for (int j = 0; j < 4; ++j) { v[j] = *(const f32x4*)(lf + tid * 16 + 4 * j);
#pragma unroll
        for (int i = 0; i < 4; ++i) { run += v[j][i]; v[j][i] = run; } }
    float sc = run;
#pragma unroll
    for (int o = 1; o < 64; o <<= 1) { const float n = __shfl_up(sc, o); if (lane >= o) sc += n; }
    __syncthreads();
    if (lane == 63) wt[wid] = sc;
    __syncthreads();
    float pre = sc - run;
    for (int w = 0; w < wid; ++w) pre += wt[w];
#pragma unroll
    for (int j = 0; j < 4; ++j) { f32x4 r;
#pragma unroll
        for (int i = 0; i < 4; ++i) r[i] = -(pre + v[j][i]) * LOG2E;
        *(f32x4*)(cb + tid * 16 + 4 * j) = r; }
    __syncthreads();
}

__global__ void __launch_bounds__(512) fwd_megakernel(P p) {
    extern __shared__ __attribute__((aligned(16))) unsigned char lds_raw[];
    LAS unsigned char* L = (LAS unsigned char*)lds_raw;
    cg::grid_group grid = cg::this_grid();
    unsigned char* ws = p.ws;
    const int G = gridDim.x, c = blockIdx.x;
    const int wv = __builtin_amdgcn_readfirstlane(threadIdx.x >> 6);
    bf16_t* qkv = (bf16_t*)(ws + WS_QKV); bf16_t* zbuf = (bf16_t*)(ws + WS_Z); bf16_t* gbuf = (bf16_t*)(ws + WS_G);

#ifndef PHM
#define PHM 63
#endif
    if (PHM & 1) p0_prologue(L, p);
    grid.sync();

    if ((PHM & 2) && c < 64) cumsum_seq(L, (const float*)(ws + WS_LOGF) + (size_t)c * SEQ, (float*)(ws + WS_CB) + (size_t)c * SEQ, wv);
    if (PHM & 2) {
        pg8::Gemm g{(const bf16_t*)(ws + WS_H), (const bf16_t*)(ws + WS_BT1), M, N1, DM}; pg8::StaticOrder S; S.init(M, N1, G, c);
        Epi1 E{qkv, zbuf, gbuf, (const float*)(ws + WS_COS), (const float*)(ws + WS_SIN), (float*)(ws + WS_KN2)};
        pg8::gemm_phase<Epi1, pg8::StaticOrder, true, true>(L, g, S, E, wv);
    }
    grid.sync();

    if (PHM & 4) {
        const float lam = ((const float*)(ws + WS_CTL))[512];
        AttnArgs A{qkv, (const float*)(ws + WS_CB), zbuf, (bf16_t*)(ws + WS_Y), (float*)(ws + WS_PARK), (const float*)(ws + WS_KN2), (unsigned*)(ws + WS_CTL), p.g_subln, lam};
        attn_phase(L, A, wv);
    }
    grid.sync();

    if (PHM & 8) {
        pg8::Gemm g{(const bf16_t*)(ws + WS_Y), (const bf16_t*)(ws + WS_BT3A), 2 * M, 2 * DM, 512}; Sched3a S; S.so.init(M, DM, G, c);
        Epi3a E{gbuf, (bf16_t*)(ws + WS_T), (bf16_t*)(ws + WS_MERGED)};
        pg8::gemm_phase<Epi3a, Sched3a, true, true>(L, g, S, E, wv);
    }
    grid.sync();

    if (PHM & 16) {
        pg8::Gemm g{(const bf16_t*)(ws + WS_MERGED), (const bf16_t*)(ws + WS_BT3B), M, DM, DM}; pg8::StaticOrder S; S.init(M, DM, G, c);
        Epi3b E{(bf16_t*)(ws + WS_Z), (float*)(ws + WS_SSQ)};
        pg8::gemm_phase<Epi3b, pg8::StaticOrder, true, true>(L, g, S, E, wv);
    }
    grid.sync();

    if (PHM & 32) {
        const float* ssq = (const float*)(ws + WS_SSQ);
        const int t4_ = wv * 64 + lane_now();
        const int gtid = c * 512 + t4_, gsz = G * 512;
        for (int i = gtid; i < M * 256; i += gsz) {
            const int row = i >> 8, c4 = i & 255;
            const u32x2 yw = *(const u32x2*)((const bf16_t*)(ws + WS_Z) + (size_t)i * 4); const f32x4 yv = {bf_lo(yw.x), bf_hi(yw.x), bf_lo(yw.y), bf_hi(yw.y)};
            const f32x4 xv = *(const f32x4*)(p.x + (size_t)i * 4), gv = *(const f32x4*)(p.g_post + c4 * 4);
            const float rs = 1.0f / sqrtf(ssq[row] * (1.0f / 1024.0f) + 1e-6f);
            *(f32x4*)(p.out + (size_t)i * 4) = xv + yv * rs * gv;
        }
    }
}
}

extern "C" void kernel_launch(void* const* d_in, const int* in_sizes, int n_in, void* d_out, int out_size, void* d_ws, size_t ws_size, hipStream_t stream) {
    static int grid = 0;
    if (grid == 0) {
        if (n_in != 12 || ws_size < mk::WS_END) { fprintf(stderr, "kernel_launch: unexpected n_in %d / ws_size %zu\n", n_in, ws_size); grid = -1; return; }
        int dev = 0, cus = 0, per_cu = 0;
        hipGetDevice(&dev); hipDeviceGetAttribute(&cus, hipDeviceAttributeMultiprocessorCount, dev);
        if (hipFuncSetAttribute((const void*)mk::fwd_megakernel, hipFuncAttributeMaxDynamicSharedMemorySize, mk::LDS_BYTES) != hipSuccess) { fprintf(stderr, "kernel_launch: hipFuncSetAttribute failed\n"); grid = -1; return; }
        if (hipOccupancyMaxActiveBlocksPerMultiprocessor(&per_cu, (const void*)mk::fwd_megakernel, 512, mk::LDS_BYTES) != hipSuccess || per_cu < 1) { fprintf(stderr, "kernel_launch: occupancy query says %d\n", per_cu); per_cu = 1; }
        (void)hipGetLastError();
        grid = cus;
    }
    if (grid < 0) return;
    mk::P p{};
    p.x = (const float*)d_in[0]; p.g_pre = (const float*)d_in[1]; p.w_in = (const float*)d_in[2]; p.b_forget = (const float*)d_in[3];
    p.lq1 = (const float*)d_in[4]; p.lk1 = (const float*)d_in[5]; p.lq2 = (const float*)d_in[6]; p.lk2 = (const float*)d_in[7];
    p.g_subln = (const float*)d_in[8]; p.w_branch = (const float*)d_in[9]; p.w_out = (const float*)d_in[10]; p.g_post = (const float*)d_in[11];
    p.out = (float*)d_out; p.ws = (unsigned char*)d_ws;
    void* args[] = {&p};
    hipError_t e = hipLaunchCooperativeKernel((const void*)mk::fwd_megakernel, dim3(grid), dim3(512), args, mk::LDS_BYTES, stream);
    if (e != hipSuccess) fprintf(stderr, "cooperative launch failed: %s (grid %d)\n", hipGetErrorString(e), grid);
}
```

```cpp
#include <hip/hip_runtime.h>
#include <hip/hip_cooperative_groups.h>
#include <cstdio>
#include <cstdint>
namespace cg = cooperative_groups;
namespace pg8 {
#define PG8_LAS __attribute__((address_space(3)))
typedef unsigned short bf16_t;
typedef short bf16x8 __attribute__((ext_vector_type(8)));
typedef float f32x4 __attribute__((ext_vector_type(4)));
typedef unsigned u32x4 __attribute__((ext_vector_type(4)));
constexpr int BM = 256, BK = 64, HALF = 128, HTB = HALF * BK * 2  , STAGE_BYTES = 8 * HTB, NXCD = 8, WGM = 8;

__host__ __device__ __forceinline__ int lds_byte(int r, int c) { const int st = (r >> 4) * 2 + (c >> 5), rr = r & 15, cc = c & 31, ob = rr * 64 + cc * 2; return st * 1024 + (ob ^ (((ob >> 9) & 1) << 5)); }
__host__ __device__ __forceinline__ void stage_rc(int b, int& R, int& C) { const int st = b / 1024, sb = b % 1024, swz = sb ^ (((sb >> 9) & 1) << 5); R = (st >> 1) * 16 + swz / 64; C = (st & 1) * 32 + (swz % 64) / 2; }
__host__ __device__ __forceinline__ int perm32(int rho) { const int n = rho >> 4, i = rho & 15; return 8 * (i >> 2) + 4 * n + (i & 3); }

struct Unit { int pm, pn; };
struct Gemm { const bf16_t* A; const bf16_t* Bt; int M, N, K; };

struct StaticOrder {
    int nM, nN, nwg, G, c;
    __host__ __device__ void init(int M, int N, int G_, int c_) { nM = M / BM; nN = N / BM; nwg = nM * nN; G = G_; c = c_; }
    __host__ __device__ bool next(int i, Unit& u) const {
        const long L = (long)i * G + c; if (L >= nwg) return false;
        int wgid = (int)L; { const int q = nwg / NXCD, r = nwg % NXCD, xcd = wgid % NXCD, off = wgid / NXCD; wgid = (xcd < r ? xcd * (q + 1) : r * (q + 1) + (xcd - r) * q) + off; }
        const int nig = WGM * nN, gid = wgid / nig, fm = gid * WGM, gsz = (nM - fm) < WGM ? (nM - fm) : WGM;
        u.pm = fm + ((wgid % nig) % gsz); u.pn = (wgid % nig) / gsz; return true;
    }
    __device__ __forceinline__ void a_ready(const Unit&) const {}
    __device__ __forceinline__ void done(const Unit&) const {}
};

__device__ __forceinline__ unsigned cvt_pk_bf16(float lo, float hi) { unsigned r; asm volatile("v_cvt_pk_bf16_f32 %0, %1, %2" : "=v"(r) : "v"(lo), "v"(hi)); return r; }
typedef float f32x2 __attribute__((ext_vector_type(2)));
__device__ __forceinline__ f32x2 gelu_pk(f32x2 v) {
    const f32x2 av = __builtin_elementwise_abs(v), d = av * 0.2316418882f + 1.0f;
    f32x2 t; t.x = __builtin_amdgcn_rcpf(d.x); t.y = __builtin_amdgcn_rcpf(d.y);
    f32x2 q = t * 0.5307027145f + (-0.7265760135f); q = q * t + 0.7107068705f; q = q * t + (-0.142248368f); q = q * t + 0.127414796f; q = q * t;
    const f32x2 s = (v * v) * (-0.72134752044f);
    f32x2 e; e.x = __builtin_amdgcn_exp2f(s.x); e.y = __builtin_amdgcn_exp2f(s.y);
    const f32x2 m = v * (q * e), r = v - m;
    f32x2 o; o.x = v.x < 0.f ? m.x : r.x; o.y = v.y < 0.f ? m.y : r.y; return o;
}

template <int ACT  > struct EpiBf16 {
    static constexpr bool PERM = true, AFTER_DRAIN = false; static_assert(ACT == 0 || ACT == 1, "EpiBf16: ACT is 0 (none) or 1 (gelu_pk)");
    bf16_t* O; int ldc; const float* bias; int split_cols; size_t split_stride; float scale0;
    __device__ __forceinline__ void operator()(const f32x4 (&acc)[2][2][4][2], const Unit& u, int wr, int wc, int fr, int fq) const {
        const int row0 = u.pm * BM + wr * 64 + fr; int colt = u.pn * BM; bf16_t* base = O;
        float sc = 1.f; if (split_cols) { const int t = colt / split_cols; base += (size_t)t * split_stride; colt -= t * split_cols; if (t == 0) sc = scale0; }
        const int col0 = colt + wc * 32 + 8 * fq, bcol0 = u.pn * BM + wc * 32 + 8 * fq;
        f32x4 bv[2][2];
#pragma unroll
        for (int bj = 0; bj < 2; ++bj)
#pragma unroll
            for (int n = 0; n < 2; ++n) bv[bj][n] = bias ? *(const f32x4*)(bias + bcol0 + bj * HALF + 4 * n) : (f32x4){0.f, 0.f, 0.f, 0.f};
#pragma unroll
        for (int ai = 0; ai < 2; ++ai)
#pragma unroll
            for (int m = 0; m < 4; ++m) { bf16_t* rowp = base + (size_t)(row0 + ai * HALF + m * 16) * ldc + col0;
#pragma unroll
                for (int bj = 0; bj < 2; ++bj) { f32x4 v0 = acc[ai][bj][m][0] + bv[bj][0], v1 = acc[ai][bj][m][1] + bv[bj][1];
                    if (ACT == 1) { f32x2 a = gelu_pk((f32x2){v0[0], v0[1]}), b = gelu_pk((f32x2){v0[2], v0[3]}), c = gelu_pk((f32x2){v1[0], v1[1]}), d = gelu_pk((f32x2){v1[2], v1[3]});
                        v0 = (f32x4){a.x, a.y, b.x, b.y}; v1 = (f32x4){c.x, c.y, d.x, d.y}; }
                    v0 = v0 * sc; v1 = v1 * sc; u32x4 w; w.x = cvt_pk_bf16(v0[0], v0[1]); w.y = cvt_pk_bf16(v0[2], v0[3]); w.z = cvt_pk_bf16(v1[0], v1[1]); w.w = cvt_pk_bf16(v1[2], v1[3]);
                    *(u32x4*)(rowp + bj * HALF) = w; } }
    }
};

template <class Epi, class Sched, bool ALIGN_EPI = false, bool SP2 = false>
__device__ __forceinline__ void gemm_phase(PG8_LAS unsigned char* lds, const Gemm g, const Sched& S, const Epi& E, const int wv  ) {
    int lane_; asm volatile("v_mbcnt_lo_u32_b32 %0, -1, 0\n\tv_mbcnt_hi_u32_b32 %0, -1, %0" : "=v"(lane_));
    const int tid_ = wv * 64 + lane_;
    const int tid = tid_, wid = __builtin_amdgcn_readfirstlane(tid >> 6), lane = tid & 63, wr = wid >> 2, wc = wid & 3, fr = lane & 15, fq = lane >> 4;
    const int K = g.K, nt = K / BK;
    unsigned voffA[2], voffB[2];
#pragma unroll
    for (int i = 0; i < 2; ++i) { int R, C; stage_rc(tid * 16 + i * 8192, R, C); const int Rb = Epi::PERM ? ((R & ~31) + perm32(R & 31)) : R;
        voffA[i] = (unsigned)(R * K + C) * 2u; voffB[i] = (unsigned)(Rb * K + C) * 2u; }
    const size_t kstep = (size_t)(BK * 2);
    const size_t hstep = (size_t)HALF * K * 2;
    const size_t tstep = 2 * hstep;
    const unsigned ldsw = (unsigned)wid * 1024u;
    const int aoff = lds_byte(wr * 64 + fr, fq * 8), boff = lds_byte(wc * 32 + fr, fq * 8);
#define PG8_SA(b, h) (((b) * 2 + (h)) * HTB)
#define PG8_SB(b, h) ((4 + (b) * 2 + (h)) * HTB)
#define PG8_STAGE(bufoff, gbase, voff) do { _Pragma("unroll") for (int _i = 0; _i < 2; ++_i) \
        __builtin_amdgcn_global_load_lds((const unsigned*)((const char*)(gbase) + (voff)[_i]), (PG8_LAS unsigned*)(lds + (bufoff) + ldsw + _i * 8192), 16, 0, 0); } while (0)
#define PG8_LDA(dst, b, h) do { _Pragma("unroll") for (int m = 0; m < 4; ++m) _Pragma("unroll") for (int k = 0; k < 2; ++k) dst[m][k] = *(const PG8_LAS bf16x8*)(lds + PG8_SA(b, h) + aoff + m * 2048 + k * 1024); } while (0)
#define PG8_LDB(dst, b, h) do { _Pragma("unroll") for (int n = 0; n < 2; ++n) _Pragma("unroll") for (int k = 0; k < 2; ++k) dst[n][k] = *(const PG8_LAS bf16x8*)(lds + PG8_SB(b, h) + boff + n * 2048 + k * 1024); } while (0)
#define PG8_MMA(ai, bj, At, Bt) do { __builtin_amdgcn_s_setprio(1); _Pragma("unroll") for (int m = 0; m < 4; ++m) _Pragma("unroll") for (int n = 0; n < 2; ++n) _Pragma("unroll") for (int k = 0; k < 2; ++k) \
        acc[ai][bj][m][n] = __builtin_amdgcn_mfma_f32_16x16x32_bf16(Bt[n][k], At[m][k], acc[ai][bj][m][n], 0, 0, 0); __builtin_amdgcn_s_setprio(0); } while (0)
#define PG8_WAIT_V(n) asm volatile("s_waitcnt vmcnt(" #n ")" ::: "memory")
#define PG8_WAIT_L(n) asm volatile("s_waitcnt lgkmcnt(" #n ")" ::: "memory")
#define PG8_BAR __builtin_amdgcn_s_barrier()
#define PG8_SCHED __builtin_amdgcn_sched_barrier(0)
    Unit cur, nxt; int ui = 0;
    if (!S.next(0, cur)) return;
    f32x4 acc[2][2][4][2];
#pragma unroll
    for (int a = 0; a < 2; ++a)
#pragma unroll
        for (int b = 0; b < 2; ++b)
#pragma unroll
            for (int m = 0; m < 4; ++m)
#pragma unroll
                for (int n = 0; n < 2; ++n) acc[a][b][m][n] = (f32x4){0.f, 0.f, 0.f, 0.f};
    bf16x8 At[4][2], B0[2][2], B1[2][2];
    const char* cA = (const char*)g.A + (size_t)cur.pm * tstep; const char* cB = (const char*)g.Bt + (size_t)cur.pn * tstep;
    S.a_ready(cur);
    if constexpr (SP2) {
        PG8_STAGE(PG8_SB(0, 0), cB, voffB); PG8_STAGE(PG8_SB(0, 1), cB + hstep, voffB); PG8_STAGE(PG8_SA(0, 0), cA, voffA); PG8_STAGE(PG8_SA(0, 1), cA + hstep, voffA);
        if (wr == 1) PG8_BAR;
        PG8_WAIT_V(2); PG8_BAR;
        PG8_STAGE(PG8_SB(1, 0), cB + kstep, voffB); PG8_STAGE(PG8_SA(1, 0), cA + kstep, voffA); PG8_STAGE(PG8_SB(1, 1), cB + hstep + kstep, voffB);
        PG8_WAIT_V(6); PG8_BAR;
    } else {
        PG8_STAGE(PG8_SB(0, 0), cB, voffB); PG8_STAGE(PG8_SA(0, 0), cA, voffA); PG8_STAGE(PG8_SB(0, 1), cB + hstep, voffB); PG8_STAGE(PG8_SA(0, 1), cA + hstep, voffA);
        if (wr == 1) PG8_BAR;
        PG8_WAIT_V(4); PG8_BAR;
        PG8_STAGE(PG8_SB(1, 0), cB + kstep, voffB); PG8_STAGE(PG8_SA(1, 0), cA + kstep, voffA); PG8_STAGE(PG8_SB(1, 1), cB + hstep + kstep, voffB);
        PG8_WAIT_V(6); PG8_BAR;
    }
    for (;;) {
        const bool has_next = S.next(ui + 1, nxt);
        const char* nA = has_next ? (const char*)g.A + (size_t)nxt.pm * tstep : cA; const char* nB = has_next ? (const char*)g.Bt + (size_t)nxt.pn * tstep : cB;
        for (int t = 0; t < nt; t += 2) {
            const bool last = (t == nt - 2);
            const char* a1 = cA + (size_t)(t + 1) * kstep;
            const char* a2 = last ? nA : cA + (size_t)(t + 2) * kstep; const char* b2 = last ? nB : cB + (size_t)(t + 2) * kstep;
            const char* a3 = a2 + kstep; const char* b3 = b2 + kstep;
            if (last && has_next) S.a_ready(nxt);
            if constexpr (SP2) {
            PG8_LDB(B0, 0, 0); PG8_LDB(B1, 0, 1); PG8_SCHED; PG8_LDA(At, 0, 0); PG8_STAGE(PG8_SA(1, 1), a1 + hstep, voffA);
            PG8_WAIT_V(8); PG8_WAIT_L(0); PG8_BAR; PG8_MMA(0, 0, At, B0); PG8_MMA(0, 1, At, B1); PG8_BAR; PG8_SCHED;
            PG8_LDA(At, 0, 1); PG8_STAGE(PG8_SB(0, 0), b2, voffB); PG8_STAGE(PG8_SB(0, 1), b2 + hstep, voffB); PG8_STAGE(PG8_SA(0, 0), a2, voffA);
            PG8_WAIT_V(8); PG8_WAIT_L(0); PG8_BAR; PG8_MMA(1, 0, At, B0); PG8_MMA(1, 1, At, B1); PG8_BAR; PG8_SCHED;
            PG8_LDB(B0, 1, 0); PG8_LDB(B1, 1, 1); PG8_SCHED; PG8_LDA(At, 1, 0); PG8_STAGE(PG8_SA(0, 1), a2 + hstep, voffA);
            PG8_WAIT_V(8); PG8_WAIT_L(0); PG8_BAR; PG8_MMA(0, 0, At, B0); PG8_MMA(0, 1, At, B1); PG8_BAR; PG8_SCHED;
            PG8_LDA(At, 1, 1); PG8_STAGE(PG8_SB(1, 0), b3, voffB); PG8_STAGE(PG8_SB(1, 1), b3 + hstep, voffB); PG8_STAGE(PG8_SA(1, 0), a3, voffA);
            PG8_WAIT_V(8); PG8_WAIT_L(0); PG8_BAR; PG8_MMA(1, 0, At, B0); PG8_MMA(1, 1, At, B1); PG8_BAR; PG8_SCHED;
            } else {
            PG8_LDB(B0, 0, 0); PG8_SCHED; PG8_LDA(At, 0, 0); PG8_STAGE(PG8_SA(1, 1), a1 + hstep, voffA);
            PG8_WAIT_L(8); PG8_BAR; PG8_WAIT_L(0); PG8_MMA(0, 0, At, B0); PG8_BAR; PG8_SCHED;
            PG8_LDB(B1, 0, 1); PG8_STAGE(PG8_SB(0, 0), b2, voffB);
            PG8_BAR; PG8_WAIT_L(0); PG8_MMA(0, 1, At, B1); PG8_BAR;
            PG8_LDA(At, 0, 1); PG8_STAGE(PG8_SA(0, 0), a2, voffA);
            PG8_BAR; PG8_WAIT_L(0); PG8_MMA(1, 0, At, B0); PG8_BAR; PG8_SCHED;
            PG8_STAGE(PG8_SB(0, 1), b2 + hstep, voffB);
            PG8_WAIT_V(6); PG8_BAR; PG8_MMA(1, 1, At, B1); PG8_BAR;
            PG8_LDB(B0, 1, 0); PG8_SCHED; PG8_LDA(At, 1, 0); PG8_STAGE(PG8_SA(0, 1), a2 + hstep, voffA);
            PG8_WAIT_L(8); PG8_BAR; PG8_WAIT_L(0); PG8_MMA(0, 0, At, B0); PG8_BAR; PG8_SCHED;
            PG8_LDB(B1, 1, 1); PG8_STAGE(PG8_SB(1, 0), b3, voffB);
            PG8_BAR; PG8_WAIT_L(0); PG8_MMA(0, 1, At, B1); PG8_BAR;
            PG8_LDA(At, 1, 1); PG8_STAGE(PG8_SA(1, 0), a3, voffA);
            PG8_BAR; PG8_WAIT_L(0); PG8_MMA(1, 0, At, B0); PG8_BAR; PG8_SCHED;
            PG8_STAGE(PG8_SB(1, 1), b3 + hstep, voffB);
            PG8_WAIT_V(6); PG8_BAR; PG8_MMA(1, 1, At, B1); PG8_BAR;
            }
        }
        if constexpr (ALIGN_EPI) { if (wr == 0) PG8_BAR; }
        if constexpr (!Epi::AFTER_DRAIN) { E(acc, cur, wr, wc, fr, fq); S.done(cur); }
        if (!has_next) break;
#pragma unroll
        for (int a = 0; a < 2; ++a)
#pragma unroll
            for (int b = 0; b < 2; ++b)
#pragma unroll
                for (int m = 0; m < 4; ++m)
#pragma unroll
                    for (int n = 0; n < 2; ++n) acc[a][b][m][n] = (f32x4){0.f, 0.f, 0.f, 0.f};
        cur = nxt; cA = nA; cB = nB; ++ui;
        if constexpr (ALIGN_EPI) { if (wr == 1) PG8_BAR; }
    }
    PG8_WAIT_V(0);
    if constexpr (!ALIGN_EPI) { if (wr == 0) PG8_BAR; }
    PG8_BAR;
    if constexpr (Epi::AFTER_DRAIN) { E.fused(acc, cur, wr, wc, fr, fq, lds, wid, lane); S.done(cur); }
#undef PG8_SA
#undef PG8_SB
#undef PG8_STAGE
#undef PG8_LDA
#undef PG8_LDB
#undef PG8_MMA
#undef PG8_WAIT_V
#undef PG8_WAIT_L
#undef PG8_BAR
#undef PG8_SCHED
}
}

#define LAS __attribute__((address_space(3)))
namespace mk {
using pg8::bf16_t; using pg8::f32x4; using pg8::u32x4; using pg8::Unit;
typedef short bf16x8 __attribute__((ext_vector_type(8)));
typedef short s16x4 __attribute__((ext_vector_type(4)));
typedef float f32x16 __attribute__((ext_vector_type(16)));
typedef unsigned u32x2 __attribute__((ext_vector_type(2)));

constexpr int M = 65536, DM = 1024, SEQ = 8192, NBATCH = 8, NIN = 6152, N1 = 6144, NITEMS = 3072;
constexpr size_t MiB = (size_t)1 << 20;
constexpr size_t WS_CTL = 0, WS_BT1 = 1 * MiB, WS_BT3A = 13 * MiB, WS_BT3B = 15 * MiB, WS_COS = 17 * MiB, WS_SIN = 18 * MiB, WS_LOGF = 19 * MiB, WS_CB = 21 * MiB,
                 WS_SSQ = 23 * MiB, WS_PARK = 24 * MiB, WS_ITEMS = 56 * MiB, WS_KN2 = 57 * MiB, WS_G = 64 * MiB, WS_QKV = 320 * MiB, WS_Z = 704 * MiB, WS_H = 832 * MiB, WS_Y = WS_H,
                 WS_T = 320 * MiB, WS_MERGED = 576 * MiB, WS_END = 960 * MiB;
constexpr size_t SB = (size_t)NBATCH * 8 * SEQ * 64;
constexpr float C2 = 0.125f * 1.4426950408889634f;
constexpr float LOG2E = 1.4426950408889634f;
constexpr int LDS_BYTES = 131072 + 256;

__device__ __forceinline__ unsigned pk_bf16(float lo, float hi) {
    typedef float f32x2_t __attribute__((ext_vector_type(2))); typedef __bf16 bf16x2_t __attribute__((ext_vector_type(2)));
    f32x2_t v = {lo, hi}; bf16x2_t b = __builtin_convertvector(v, bf16x2_t); return __builtin_bit_cast(unsigned, b); }
__device__ __forceinline__ bf16_t bf16_1(float v) { return (bf16_t)(pk_bf16(v, 0.f) & 0xffffu); }
__device__ __forceinline__ float bf_lo(unsigned w) { return __uint_as_float(w << 16); }
__device__ __forceinline__ float bf_hi(unsigned w) { return __uint_as_float(w & 0xffff0000u); }
__device__ __forceinline__ float bf1(bf16_t v) { return __uint_as_float((unsigned)v << 16); }
__device__ __forceinline__ float sigmoid_(float v) { return __builtin_amdgcn_rcpf(1.f + __expf(-v)); }
__device__ __forceinline__ float silu_(float v) { return v * sigmoid_(v); }
__device__ __forceinline__ u32x4 pack8(const f32x4 a, const f32x4 b) { u32x4 w; w.x = pk_bf16(a[0], a[1]); w.y = pk_bf16(a[2], a[3]); w.z = pk_bf16(b[0], b[1]); w.w = pk_bf16(b[2], b[3]); return w; }

struct Epi1 {
    static constexpr bool PERM = true, AFTER_DRAIN = false;
    bf16_t* qkv; bf16_t* z; bf16_t* g; const float* cs; const float* sn; float* kn2;
    __device__ __forceinline__ void operator()(const f32x4 (&acc)[2][2][4][2], const Unit& u, int wr, int wc, int fr, int fq) const {
        const int pn = u.pn; const int row0 = u.pm * 256 + wr * 64 + fr; const int ct = wc * 32 + 8 * fq;
        if (pn >= 16) {
#pragma unroll
            for (int ai = 0; ai < 2; ++ai)
#pragma unroll
                for (int m = 0; m < 4; ++m) { const int row = row0 + ai * 128 + m * 16; bf16_t* rp = g + (size_t)row * 2048 + (pn - 16) * 256 + ct;
#pragma unroll
                    for (int bj = 0; bj < 2; ++bj) { f32x4 v0 = acc[ai][bj][m][0], v1 = acc[ai][bj][m][1];
#pragma unroll
                        for (int i = 0; i < 4; ++i) { v0[i] = sigmoid_(v0[i]); v1[i] = sigmoid_(v1[i]); }
                        *(u32x4*)(rp + bj * 128) = pack8(v0, v1); } }
        } else if ((pn & 7) >= 6) {
            bf16_t* zz = z + (pn >= 8 ? (size_t)M * 512 : (size_t)0);
#pragma unroll
            for (int ai = 0; ai < 2; ++ai)
#pragma unroll
                for (int m = 0; m < 4; ++m) { const int row = row0 + ai * 128 + m * 16; bf16_t* rp = zz + (size_t)row * 512 + (pn & 1) * 256 + ct;
#pragma unroll
                    for (int bj = 0; bj < 2; ++bj) { f32x4 v0 = acc[ai][bj][m][0], v1 = acc[ai][bj][m][1];
#pragma unroll
                        for (int i = 0; i < 4; ++i) { v0[i] = silu_(v0[i]); v1[i] = silu_(v1[i]); }
                        *(u32x4*)(rp + bj * 128) = pack8(v0, v1); } }
        } else if (pn >= 8 && pn < 12) {
            bf16_t* buf = qkv + (size_t)(pn < 10 ? 3 : 4) * SB; const float sc = pn < 10 ? C2 : 1.f;
#pragma unroll
            for (int ai = 0; ai < 2; ++ai)
#pragma unroll
                for (int m = 0; m < 4; ++m) { const int row = row0 + ai * 128 + m * 16; const int b = row >> 13, s = row & (SEQ - 1);
#pragma unroll
                    for (int bj = 0; bj < 2; ++bj) { const int colp = (pn & 1) * 256 + bj * 128 + ct; const int strm = colp >> 6, a = (colp & 63) >> 3;
                        const f32x4 c4 = *(const f32x4*)(cs + s * 32 + 4 * a), s4 = *(const f32x4*)(sn + s * 32 + 4 * a);
                        const f32x4 v0 = acc[ai][bj][m][0], v1 = acc[ai][bj][m][1];
                        const f32x4 lo = (v0 * c4 - v1 * s4) * sc, hi = (v1 * c4 + v0 * s4) * sc;
                        bf16_t* dst = buf + ((size_t)(b * 8 + strm) * SEQ + s) * 64 + 4 * a;
                        u32x2 w0, w1; w0.x = pk_bf16(lo[0], lo[1]); w0.y = pk_bf16(lo[2], lo[3]); w1.x = pk_bf16(hi[0], hi[1]); w1.y = pk_bf16(hi[2], hi[3]);
                        *(u32x2*)dst = w0; *(u32x2*)(dst + 32) = w1; } }
        } else {
            bf16_t* buf = qkv + (size_t)(pn >= 12 ? 5 : (pn >> 1)) * SB; const float sc = pn < 2 ? C2 : 1.f;
#pragma unroll
            for (int ai = 0; ai < 2; ++ai)
#pragma unroll
                for (int m = 0; m < 4; ++m) { const int row = row0 + ai * 128 + m * 16; const int b = row >> 13, s = row & (SEQ - 1);
#pragma unroll
                    for (int bj = 0; bj < 2; ++bj) { const int colp = (pn & 1) * 256 + bj * 128 + ct; const int strm = colp >> 6, d = colp & 63;
                        const f32x4 v0 = acc[ai][bj][m][0] * sc, v1 = acc[ai][bj][m][1] * sc;
                        *(u32x4*)(buf + ((size_t)(b * 8 + strm) * SEQ + s) * 64 + d) = pack8(v0, v1);
                        if (pn == 2 || pn == 3) {
                            float ps = (v0[0] * v0[0] + v0[1] * v0[1]) + (v0[2] * v0[2] + v0[3] * v0[3]) + (v1[0] * v1[0] + v1[1] * v1[1]) + (v1[2] * v1[2] + v1[3] * v1[3]);
                            ps += __shfl_xor(ps, 16); ps += __shfl_xor(ps, 32);
                            if (fq == 0) atomicAdd(kn2 + (size_t)(b * 8 + strm) * SEQ + s, ps); } } }
        }
    }
};

struct Sched3a {
    pg8::StaticOrder so;
    __device__ bool next(int i, Unit& u) const { if (!so.next(i >> 1, u)) return false; const int br = i & 1; u.pm += 256 * br; u.pn += 4 * br; return true; }
    __device__ __forceinline__ void a_ready(const Unit&) const {}
    __device__ __forceinline__ void done(const Unit&) const {}
};
struct Epi3a {
    static constexpr bool PERM = true, AFTER_DRAIN = false;
    const bf16_t* g; bf16_t* T; bf16_t* merged;
    __device__ __forceinline__ void operator()(const f32x4 (&acc)[2][2][4][2], const Unit& u, int wr, int wc, int fr, int fq) const {
        const int br = u.pm >= 256 ? 1 : 0; const int pm = u.pm - 256 * br, pn = u.pn - 4 * br;
        const int row0 = pm * 256 + wr * 64 + fr; const int col0 = pn * 256 + wc * 32 + 8 * fq;
#pragma unroll
        for (int ai = 0; ai < 2; ++ai)
#pragma unroll
            for (int m = 0; m < 4; ++m) { const int row = row0 + ai * 128 + m * 16;
#pragma unroll
                for (int bj = 0; bj < 2; ++bj) { const int col = col0 + bj * 128;
                    const u32x4 gw = *(const u32x4*)(g + (size_t)row * 2048 + br * 1024 + col);
                    const f32x4 g0 = {bf_lo(gw.x), bf_hi(gw.x), bf_lo(gw.y), bf_hi(gw.y)}, g1 = {bf_lo(gw.z), bf_hi(gw.z), bf_lo(gw.w), bf_hi(gw.w)};
                    bf16_t* tp = T + (size_t)row * 1024 + col;
                    if (br == 0) { *(u32x4*)tp = pack8(g0 * acc[ai][bj][m][0], g1 * acc[ai][bj][m][1]); }
                    else { const u32x4 tw = *(const u32x4*)tp;
                        const f32x4 t0 = {bf_lo(tw.x), bf_hi(tw.x), bf_lo(tw.y), bf_hi(tw.y)}, t1 = {bf_lo(tw.z), bf_hi(tw.z), bf_lo(tw.w), bf_hi(tw.w)};
                        *(u32x4*)(merged + (size_t)row * 1024 + col) = pack8(t0 + g0 * acc[ai][bj][m][0], t1 + g1 * acc[ai][bj][m][1]); } } }
    }
};
struct Epi3b {
    static constexpr bool PERM = true, AFTER_DRAIN = false;
    bf16_t* y; float* ssq;
    __device__ __forceinline__ void operator()(const f32x4 (&acc)[2][2][4][2], const Unit& u, int wr, int wc, int fr, int fq) const {
        const int row0 = u.pm * 256 + wr * 64 + fr; const int col0 = u.pn * 256 + wc * 32 + 8 * fq;
#pragma unroll
        for (int ai = 0; ai < 2; ++ai)
#pragma unroll
            for (int m = 0; m < 4; ++m) { const int row = row0 + ai * 128 + m * 16; float s = 0.f;
#pragma unroll
                for (int bj = 0; bj < 2; ++bj) { const f32x4 v0 = acc[ai][bj][m][0], v1 = acc[ai][bj][m][1];
                    *(u32x4*)(y + (size_t)row * 1024 + col0 + bj * 128) = pack8(v0, v1);
                    s += (v0[0] * v0[0] + v0[1] * v0[1]) + (v0[2] * v0[2] + v0[3] * v0[3]) + (v1[0] * v1[0] + v1[1] * v1[1]) + (v1[2] * v1[2] + v1[3] * v1[3]); }
                s += __shfl_xor(s, 16); s += __shfl_xor(s, 32);
                if (fq == 0) atomicAdd(ssq + row, s); }
    }
};

constexpr int A_KB = 8448  , A_VBASE = 2 * A_KB, A_VB = 16384, A_WSF = A_VBASE + 2 * A_VB, A_MISC = A_WSF + 8 * 128, A_STAGE = 61440  ;
typedef short v4i16_t __attribute__((ext_vector_type(4)));
__device__ __forceinline__ s16x4 tr_read(LAS unsigned char* p) { return __builtin_bit_cast(s16x4, __builtin_amdgcn_ds_read_tr16_b64_v4i16((LAS v4i16_t*)p)); }
__device__ __forceinline__ float half_max(float m) { auto rr = __builtin_amdgcn_permlane32_swap(__float_as_uint(m), __float_as_uint(m), false, false); return fmaxf(__uint_as_float(rr[0]), __uint_as_float(rr[1])); }
__device__ __forceinline__ float half_sum(float m) { auto rr = __builtin_amdgcn_permlane32_swap(__float_as_uint(m), __float_as_uint(m), false, false); return __uint_as_float(rr[0]) + __uint_as_float(rr[1]); }

template <bool BIAS>
__device__ __forceinline__ void qk_tile(LAS unsigned char* Kb, const bf16x8 (&qr)[4], unsigned ka_off, int hi, f32x16& s0, f32x16& s1) {
    if (BIAS) {
#pragma unroll
        for (int j = 0; j < 4; ++j) { const f32x4 b0 = *(LAS f32x4*)(Kb + 8192 + (8 * j + 4 * hi) * 4), b1 = *(LAS f32x4*)(Kb + 8192 + 128 + (8 * j + 4 * hi) * 4);
#pragma unroll
            for (int i = 0; i < 4; ++i) { s0[4 * j + i] = b0[i]; s1[4 * j + i] = b1[i]; } }
    } else { s0 = f32x16{}; s1 = f32x16{}; }
#pragma unroll
    for (int s = 0; s < 4; ++s) {
        const bf16x8 k0 = *(LAS bf16x8*)(Kb + ka_off + s * 2048), k1 = *(LAS bf16x8*)(Kb + ka_off + s * 2048 + 512);
        s0 = __builtin_amdgcn_mfma_f32_32x32x16_bf16(k0, qr[s], s0, 0, 0, 0);
        s1 = __builtin_amdgcn_mfma_f32_32x32x16_bf16(k1, qr[s], s1, 0, 0, 0);
    }
}
__device__ __forceinline__ void mask_tile(f32x16& s0, f32x16& s1, int t, int qg, int hi) {
    const int kb = 64 * t + 4 * hi;
#pragma unroll
    for (int r = 0; r < 16; ++r) { const int kv = kb + (r & 3) + 8 * (r >> 2); if (kv > qg) s0[r] = -INFINITY; if (kv + 32 > qg) s1[r] = -INFINITY; }
}
__device__ __forceinline__ float rowmax32(const f32x16& s0, const f32x16& s1) {
    float a = fmaxf(fmaxf(s0[0], s0[1]), s1[0]), b = fmaxf(fmaxf(s0[2], s0[3]), s1[1]); a = fmaxf(fmaxf(a, s1[2]), s1[3]);
#pragma unroll
    for (int r = 4; r < 16; r += 4) { a = fmaxf(fmaxf(a, s0[r]), s0[r + 1]); b = fmaxf(fmaxf(b, s0[r + 2]), s0[r + 3]); a = fmaxf(fmaxf(a, s1[r]), s1[r + 1]); b = fmaxf(fmaxf(b, s1[r + 2]), s1[r + 3]); }
    return half_max(fmaxf(a, b));
}
template <int NV>
__device__ __forceinline__ void softmax_pv(LAS unsigned char* Vb, LAS float* wsf, f32x16& p0, f32x16& p1, float mx, float& m_run, float& l_run, f32x16 (&o)[NV][2], unsigned vb0, unsigned vb1, int r32, int hi) {
    const float m_new = fmaxf(m_run, mx);
    const float alpha = __builtin_amdgcn_exp2f(m_run - m_new);
    m_run = m_new;
    float ls = 0.f;
#pragma unroll
    for (int r = 0; r < 16; ++r) { p0[r] = __builtin_amdgcn_exp2f(p0[r] - m_new); p1[r] = __builtin_amdgcn_exp2f(p1[r] - m_new); ls += p0[r] + p1[r]; }
    l_run = l_run * alpha + ls;
    if (__any(alpha != 1.0f)) {
        if (hi == 0) wsf[r32] = alpha;
#pragma unroll
        for (int j = 0; j < 4; ++j) { const f32x4 a = *(LAS f32x4*)(wsf + 8 * j + 4 * hi);
#pragma unroll
            for (int nv = 0; nv < NV; ++nv)
#pragma unroll
                for (int d0 = 0; d0 < 2; ++d0)
#pragma unroll
                    for (int i = 0; i < 4; ++i) o[nv][d0][4 * j + i] *= a[i]; }
    }
    bf16x8 pa[4];
    { u32x4 w;
      w.x = pk_bf16(p0[0], p0[1]); w.y = pk_bf16(p0[2], p0[3]); w.z = pk_bf16(p0[4], p0[5]); w.w = pk_bf16(p0[6], p0[7]); pa[0] = __builtin_bit_cast(bf16x8, w);
      w.x = pk_bf16(p0[8], p0[9]); w.y = pk_bf16(p0[10], p0[11]); w.z = pk_bf16(p0[12], p0[13]); w.w = pk_bf16(p0[14], p0[15]); pa[1] = __builtin_bit_cast(bf16x8, w);
      w.x = pk_bf16(p1[0], p1[1]); w.y = pk_bf16(p1[2], p1[3]); w.z = pk_bf16(p1[4], p1[5]); w.w = pk_bf16(p1[6], p1[7]); pa[2] = __builtin_bit_cast(bf16x8, w);
      w.x = pk_bf16(p1[8], p1[9]); w.y = pk_bf16(p1[10], p1[11]); w.z = pk_bf16(p1[12], p1[13]); w.w = pk_bf16(p1[14], p1[15]); pa[3] = __builtin_bit_cast(bf16x8, w); }
#pragma unroll
    for (int nv = 0; nv < NV; ++nv)
#pragma unroll
        for (int d0 = 0; d0 < 2; ++d0) {
            LAS unsigned char* vp = Vb + nv * 8192 + (d0 ? vb1 : vb0);
#pragma unroll
            for (int s = 0; s < 4; ++s) {
                const s16x4 lo = tr_read(vp + s * 2048), hh = tr_read(vp + s * 2048 + 1024);
                const bf16x8 vf = {lo[0], lo[1], lo[2], lo[3], hh[0], hh[1], hh[2], hh[3]};
                o[nv][d0] = __builtin_amdgcn_mfma_f32_32x32x16_bf16(pa[s], vf, o[nv][d0], 0, 0, 0);
            }
        }
}

__device__ __forceinline__ void qk_load(LAS unsigned char* Kb, unsigned ka_off, bf16x8 (&kf)[8]) {
#pragma unroll
    for (int s = 0; s < 4; ++s) { kf[2 * s] = *(LAS bf16x8*)(Kb + ka_off + s * 2048); kf[2 * s + 1] = *(LAS bf16x8*)(Kb + ka_off + s * 2048 + 512); }
}
template <bool BIAS>
__device__ __forceinline__ void qk_mma(LAS unsigned char* Kb, const bf16x8 (&kf)[8], const bf16x8 (&qr)[4], int hi, f32x16& s0, f32x16& s1, const f32x16& cinit) {
    if (BIAS) {
#pragma unroll
        for (int j = 0; j < 4; ++j) { const f32x4 b0 = *(LAS f32x4*)(Kb + 8192 + (8 * j + 4 * hi) * 4), b1 = *(LAS f32x4*)(Kb + 8192 + 128 + (8 * j + 4 * hi) * 4);
#pragma unroll
            for (int i = 0; i < 4; ++i) { s0[4 * j + i] = b0[i]; s1[4 * j + i] = b1[i]; } }
    }
    if (BIAS) {
#pragma unroll
        for (int s = 0; s < 4; ++s) {
            s0 = __builtin_amdgcn_mfma_f32_32x32x16_bf16(kf[2 * s], qr[s], s0, 0, 0, 0);
            s1 = __builtin_amdgcn_mfma_f32_32x32x16_bf16(kf[2 * s + 1], qr[s], s1, 0, 0, 0);
        }
    } else {
        s0 = __builtin_amdgcn_mfma_f32_32x32x16_bf16(kf[0], qr[0], cinit, 0, 0, 0);
        s1 = __builtin_amdgcn_mfma_f32_32x32x16_bf16(kf[1], qr[0], cinit, 0, 0, 0);
#pragma unroll
        for (int s = 1; s < 4; ++s) {
            s0 = __builtin_amdgcn_mfma_f32_32x32x16_bf16(kf[2 * s], qr[s], s0, 0, 0, 0);
            s1 = __builtin_amdgcn_mfma_f32_32x32x16_bf16(kf[2 * s + 1], qr[s], s1, 0, 0, 0);
        }
    }
}
__device__ __forceinline__ void v_load(LAS unsigned char* vp, s16x4 (&v)[8]) {
#pragma unroll
    for (int s = 0; s < 4; ++s) { v[2 * s] = tr_read(vp + s * 2048); v[2 * s + 1] = tr_read(vp + s * 2048 + 1024); }
}
__device__ __forceinline__ void pv_mma(const bf16x8 (&pa)[4], const s16x4 (&v)[8], f32x16& oo) {
#pragma unroll
    for (int s = 0; s < 4; ++s) { const bf16x8 vf = {v[2 * s][0], v[2 * s][1], v[2 * s][2], v[2 * s][3], v[2 * s + 1][0], v[2 * s + 1][1], v[2 * s + 1][2], v[2 * s + 1][3]};
        oo = __builtin_amdgcn_mfma_f32_32x32x16_bf16(pa[s], vf, oo, 0, 0, 0); }
}
template <int NV>
__device__ __forceinline__ void softmax_pv3(LAS unsigned char* Vb, LAS float* wsf, f32x16& p0, f32x16& p1, float mx, float& m_run, float& l_run, f32x16 (&o)[NV][2], s16x4 (&va)[8], s16x4 (&vb)[8], unsigned vb0, unsigned vb1, int r32, int hi) {
    const float m_new = fmaxf(m_run, mx);
    const float alpha = __builtin_amdgcn_exp2f(m_run - m_new);
    m_run = m_new;
    if (__any(alpha != 1.0f)) {
        if (hi == 0) wsf[r32] = alpha;
#pragma unroll
        for (int j = 0; j < 4; ++j) { const f32x4 a = *(LAS f32x4*)(wsf + 8 * j + 4 * hi);
#pragma unroll
            for (int nv = 0; nv < NV; ++nv)
#pragma unroll
                for (int d0 = 0; d0 < 2; ++d0)
#pragma unroll
                    for (int i = 0; i < 4; ++i) o[nv][d0][4 * j + i] *= a[i]; }
    }
    float ls = 0.f;
#pragma unroll
    for (int r = 0; r < 16; ++r) { p0[r] = __builtin_amdgcn_exp2f(p0[r] - m_new); p1[r] = __builtin_amdgcn_exp2f(p1[r] - m_new); ls += p0[r] + p1[r]; }
    l_run = l_run * alpha + ls;
    bf16x8 pa[4];
    { u32x4 w;
      w.x = pk_bf16(p0[0], p0[1]); w.y = pk_bf16(p0[2], p0[3]); w.z = pk_bf16(p0[4], p0[5]); w.w = pk_bf16(p0[6], p0[7]); pa[0] = __builtin_bit_cast(bf16x8, w);
      w.x = pk_bf16(p0[8], p0[9]); w.y = pk_bf16(p0[10], p0[11]); w.z = pk_bf16(p0[12], p0[13]); w.w = pk_bf16(p0[14], p0[15]); pa[1] = __builtin_bit_cast(bf16x8, w);
      w.x = pk_bf16(p1[0], p1[1]); w.y = pk_bf16(p1[2], p1[3]); w.z = pk_bf16(p1[4], p1[5]); w.w = pk_bf16(p1[6], p1[7]); pa[2] = __builtin_bit_cast(bf16x8, w);
      w.x = pk_bf16(p1[8], p1[9]); w.y = pk_bf16(p1[10], p1[11]); w.z = pk_bf16(p1[12], p1[13]); w.w = pk_bf16(p1[14], p1[15]); pa[3] = __builtin_bit_cast(bf16x8, w); }
    pv_mma(pa, va, o[0][0]);
    if (NV == 2) { v_load(Vb + 8192 + vb0, va); __builtin_amdgcn_sched_barrier(0); }
    pv_mma(pa, vb, o[0][1]);
    if (NV == 2) {
        v_load(Vb + 8192 + vb1, vb); __builtin_amdgcn_sched_barrier(0);
        pv_mma(pa, va, o[NV - 1][0]);
        pv_mma(pa, vb, o[NV - 1][1]);
    }
}

template <int NV>
__device__ __forceinline__ void v_load_ks(LAS unsigned char* Vb, unsigned vb0, unsigned vb1, int s, s16x4 (&v)[4 * NV]) {
#pragma unroll
    for (int g = 0; g < 2 * NV; ++g) { LAS unsigned char* vp = Vb + (g >> 1) * 8192 + ((g & 1) ? vb1 : vb0) + s * 2048; v[2 * g] = tr_read(vp); v[2 * g + 1] = tr_read(vp + 1024); }
}
template <int NV>
__device__ __forceinline__ void softmax_pv4(LAS unsigned char* Vb, LAS float* wsf, f32x16& p0, f32x16& p1, float mx, float& m_run, float& l_run, f32x16 (&o)[NV][2], s16x4 (&va)[4 * NV], unsigned vb0, unsigned vb1, int r32, int hi, f32x16& negm, bool& started, LAS unsigned char* Kb, unsigned ka_off, bf16x8 (&kf)[8], const bool do_next) {
    constexpr bool LAZY = (NV == 2);
    float m_new, alpha;
    if constexpr (LAZY) {
        const bool first = !started;
        if (first || __any(mx > 8.0f)) {
            const float dl = first ? mx : fmaxf(mx, 0.f);
            m_run += dl;
#pragma unroll
            for (int r = 0; r < 16; ++r) { p0[r] -= dl; p1[r] -= dl; }
#pragma unroll
            for (int r = 0; r < 16; ++r) negm[r] = -m_run;
            alpha = first ? 1.0f : __builtin_amdgcn_exp2f(-dl);
            l_run *= alpha;
        } else alpha = 1.0f;
        started = true; m_new = 0.f;
    } else {
        m_new = fmaxf(m_run, mx);
        alpha = __builtin_amdgcn_exp2f(m_run - m_new);
        m_run = m_new;
    }
    if (__any(alpha != 1.0f)) {
        if (hi == 0) wsf[r32] = alpha;
#pragma unroll
        for (int j = 0; j < 4; ++j) { const f32x4 a = *(LAS f32x4*)(wsf + 8 * j + 4 * hi);
#pragma unroll
            for (int nv = 0; nv < NV; ++nv)
#pragma unroll
                for (int d0 = 0; d0 < 2; ++d0)
#pragma unroll
                    for (int i = 0; i < 4; ++i) o[nv][d0][4 * j + i] *= a[i]; }
    }
    typedef float f32x2v __attribute__((ext_vector_type(2)));
    f32x2v ls2_ = {0.f, 0.f}; const f32x2v m2_ = {m_new, m_new};
    s16x4 vbb[4 * NV];
    u32x4 w0, w1, w2, w3;
#define PV4_E2(P, B, W, C) do { const f32x2v t_ = (f32x2v){P[B], P[B + 1]} - m2_; const f32x2v e_ = {__builtin_amdgcn_exp2f(t_.x), __builtin_amdgcn_exp2f(t_.y)}; ls2_ += e_; W[C] = pk_bf16(e_.x, e_.y); } while (0)
#define PV4_MF(W, V, G) do { const bf16x8 vf_ = {V[2 * (G)][0], V[2 * (G)][1], V[2 * (G)][2], V[2 * (G)][3], V[2 * (G) + 1][0], V[2 * (G) + 1][1], V[2 * (G) + 1][2], V[2 * (G) + 1][3]}; \
        o[(G) >> 1][(G) & 1] = __builtin_amdgcn_mfma_f32_32x32x16_bf16(__builtin_bit_cast(bf16x8, W), vf_, o[(G) >> 1][(G) & 1], 0, 0, 0); } while (0)
#define SB() __builtin_amdgcn_sched_barrier(0)
#define PV4_TR(S, G, DST) do { LAS unsigned char* vp_ = Vb + ((G) >> 1) * 8192 + (((G) & 1) ? vb1 : vb0) + (S) * 2048; DST[2 * (G)] = tr_read(vp_); DST[2 * (G) + 1] = tr_read(vp_ + 1024); } while (0)
#define PV4_KL(G) do { if (do_next) { kf[2 * (G)] = *(LAS bf16x8*)(Kb + ka_off + (G) * 2048); kf[2 * (G) + 1] = *(LAS bf16x8*)(Kb + ka_off + (G) * 2048 + 512); } } while (0)
    PV4_E2(p0, 0, w0, 0); PV4_E2(p0, 2, w0, 1); PV4_E2(p0, 4, w0, 2); PV4_E2(p0, 6, w0, 3); SB();
    if (NV == 2) {
        PV4_MF(w0, va, 0); PV4_TR(1, 0, vbb); PV4_E2(p0, 8, w1, 0); SB(); PV4_MF(w0, va, 1); PV4_TR(1, 1, vbb); PV4_E2(p0, 10, w1, 1); SB();
        PV4_MF(w0, va, 2); PV4_TR(1, 2, vbb); PV4_E2(p0, 12, w1, 2); SB(); PV4_MF(w0, va, 3); PV4_TR(1, 3, vbb); PV4_E2(p0, 14, w1, 3); SB();
        PV4_MF(w1, vbb, 0); PV4_TR(2, 0, va); PV4_E2(p1, 0, w2, 0); SB(); PV4_MF(w1, vbb, 1); PV4_TR(2, 1, va); PV4_E2(p1, 2, w2, 1); SB();
        PV4_MF(w1, vbb, 2); PV4_TR(2, 2, va); PV4_E2(p1, 4, w2, 2); SB(); PV4_MF(w1, vbb, 3); PV4_TR(2, 3, va); PV4_E2(p1, 6, w2, 3); SB();
        PV4_MF(w2, va, 0); PV4_TR(3, 0, vbb); PV4_E2(p1, 8, w3, 0); SB(); PV4_MF(w2, va, 1); PV4_TR(3, 1, vbb); PV4_E2(p1, 10, w3, 1); SB();
        PV4_MF(w2, va, 2); PV4_TR(3, 2, vbb); PV4_E2(p1, 12, w3, 2); SB(); PV4_MF(w2, va, 3); PV4_TR(3, 3, vbb); PV4_E2(p1, 14, w3, 3); SB();
        PV4_MF(w3, vbb, 0); PV4_KL(0); SB(); PV4_MF(w3, vbb, 1); PV4_KL(1); SB(); PV4_MF(w3, vbb, 2); PV4_KL(2); SB(); PV4_MF(w3, vbb, 3); PV4_KL(3); SB();
    } else {
        PV4_MF(w0, va, 0); PV4_TR(1, 0, vbb); PV4_E2(p0, 8, w1, 0); PV4_E2(p0, 10, w1, 1); SB(); PV4_MF(w0, va, 1); PV4_TR(1, 1, vbb); PV4_E2(p0, 12, w1, 2); PV4_E2(p0, 14, w1, 3); SB();
        PV4_MF(w1, vbb, 0); PV4_TR(2, 0, va); PV4_E2(p1, 0, w2, 0); PV4_E2(p1, 2, w2, 1); SB(); PV4_MF(w1, vbb, 1); PV4_TR(2, 1, va); PV4_E2(p1, 4, w2, 2); PV4_E2(p1, 6, w2, 3); SB();
        PV4_MF(w2, va, 0); PV4_TR(3, 0, vbb); PV4_E2(p1, 8, w3, 0); PV4_E2(p1, 10, w3, 1); SB(); PV4_MF(w2, va, 1); PV4_TR(3, 1, vbb); PV4_E2(p1, 12, w3, 2); PV4_E2(p1, 14, w3, 3); SB();
        PV4_MF(w3, vbb, 0); PV4_KL(0); PV4_KL(1); SB(); PV4_MF(w3, vbb, 1); PV4_KL(2); PV4_KL(3); SB();
    }
#undef PV4_TR
#undef PV4_KL
#undef PV4_E2
#undef PV4_MF
#undef SB
    l_run = (LAZY ? l_run : l_run * alpha) + (ls2_.x + ls2_.y);
}

template <int NV, bool BIAS>
__device__ __forceinline__ void attn_pass(LAS unsigned char* L, const bf16_t* __restrict__ Qp, const bf16_t* __restrict__ Kp, const bf16_t* __restrict__ Vp0, const bf16_t* __restrict__ Vp1,
                                          const float* __restrict__ cbp, int qb, f32x16 (&o)[NV][2], const int tid, const float* __restrict__ kn2p, const float gk) {
    const int lane = tid & 63, r32 = lane & 31, hi = lane >> 5;
    const int wid = __builtin_amdgcn_readfirstlane(tid >> 6);
    const int q0w = qb * 256 + wid * 32, qg = q0w + r32;
    const int NT = 4 * qb + 4, T0 = NT - 1, tmax = 4 * qb + (wid >> 1);
    bf16x8 qr[4];
#pragma unroll
    for (int s = 0; s < 4; ++s) qr[s] = *(const bf16x8*)(Qp + (size_t)(q0w + r32) * 64 + 16 * s + 8 * hi);
    int NS = NT;
    if (BIAS) {
        LAS unsigned* mw = (LAS unsigned*)(L + A_MISC);
        float q2 = 0.f;
#pragma unroll
        for (int s = 0; s < 4; ++s)
#pragma unroll
            for (int j = 0; j < 8; ++j) { const float v = __uint_as_float(((unsigned)(unsigned short)qr[s][j]) << 16); q2 += v * v; }
        const float qn = sqrtf(half_sum(q2)) * 1.02f;
        float val = cbp[qg] - qn * (gk + sqrtf(kn2p[qg]) * 1.02f) - 170.0f;
        val = fminf(val, __shfl_xor(val, 1)); val = fminf(val, __shfl_xor(val, 2)); val = fminf(val, __shfl_xor(val, 4)); val = fminf(val, __shfl_xor(val, 8)); val = fminf(val, __shfl_xor(val, 16));
        if (tid == 0) mw[2] = 0u;
        if (lane == 0) ((LAS float*)mw)[4 + wid] = val;
        __syncthreads();
        float thr = ((LAS float*)mw)[4];
#pragma unroll
        for (int w = 1; w < 8; ++w) thr = fminf(thr, ((LAS float*)mw)[4 + w]);
        if (gk >= 0.f && tid < NT && cbp[64 * tid + 63] < thr) __hip_atomic_fetch_max(mw + 2, (unsigned)(tid + 1), __ATOMIC_RELAXED, __HIP_MEMORY_SCOPE_WORKGROUP);
        __syncthreads();
        int t_stop = (int)mw[2];
        if ((NT - t_stop) & 1) t_stop -= 1;
        NS = NT - t_stop;
    }
    const int kvr = tid >> 3, chv = tid & 7;
    const bf16_t* kg = Kp + (size_t)lane * 64 + wid * 8;
    const int vxo = kvr * 64 + ((chv ^ (((kvr >> 1) & 1) << 2)) << 3);
    const bf16_t* vgx0 = Vp0 + vxo;
    const bf16_t* vgx1 = Vp1 + vxo;
    const unsigned ka_off = hi * 1024 + r32 * 16;
    const int g1 = (lane >> 4) & 1, qq = (lane & 15) >> 2, pp = lane & 3, xq = (qq >> 1) & 1;
    const unsigned vrow = (4 * hi + qq) * 128 + 32 * g1 + 8 * pp;
    const unsigned vb0 = vrow + (xq ? 64 : 0), vb1 = vrow + (xq ? 0 : 64);
    LAS float* wsf = (LAS float*)(L + A_WSF + wid * 128);
    f32x4 bst = {0.f, 0.f, 0.f, 0.f};
    float m_run = (NV == 2) ? 0.f : -1e30f, l_run = 0.f; f32x16 negm = f32x16{}; bool started = false;
#pragma unroll
    for (int nv = 0; nv < NV; ++nv) { o[nv][0] = f32x16{}; o[nv][1] = f32x16{}; }
#define ATT_LOADK(tt) do { __builtin_amdgcn_global_load_lds((const unsigned*)(kg + (size_t)(tt) * 4096), (LAS unsigned*)(L + kdst_ * A_KB + wid * 1024), 16, 0, 0); \
        if (BIAS && tid < 16) bst = *(const f32x4*)(cbp + (tt) * 64 + tid * 4); } while (0)
#define ATT_LOADV(tt) do { __builtin_amdgcn_global_load_lds((const unsigned*)(vgx0 + (size_t)(tt) * 4096), (LAS unsigned*)(L + A_VBASE + vdst_ * A_VB + wid * 1024), 16, 0, 0); \
        if (NV == 2) __builtin_amdgcn_global_load_lds((const unsigned*)(vgx1 + (size_t)(tt) * 4096), (LAS unsigned*)(L + A_VBASE + vdst_ * A_VB + 8192 + wid * 1024), 16, 0, 0); } while (0)
#define ATT_STOREK(b) do { if (BIAS && tid < 16) *(LAS f32x4*)(L + (b) * A_KB + 8192 + tid * 16) = bst; } while (0)
#define ATT_STOREV(b) do { } while (0)
    int kdst_ = 0, vdst_ = 0;
    kdst_ = 0; vdst_ = 0; ATT_LOADK(T0); ATT_LOADV(T0); ATT_STOREK(0);
    kdst_ = 1; ATT_LOADK(T0 - 1); ATT_STOREK(1);
    __syncthreads();
    f32x16 s0, s1;
    if (T0 <= tmax) { qk_tile<BIAS>(L, qr, ka_off, hi, s0, s1); mask_tile(s0, s1, T0, qg, hi); }
    __syncthreads();
    bf16x8 kf[8]; s16x4 va[4 * NV];
#define ATT_STEP(i) do { \
        const int t_ = T0 - (i); const int kb_ = ((i) + 1) & 1, vbuf_ = (i) & 1; \
        { const int tk_ = t_ - 2 > 0 ? t_ - 2 : 0, tv_ = t_ - 1 > 0 ? t_ - 1 : 0; kdst_ = vbuf_; vdst_ = kb_; ATT_LOADK(tk_); ATT_LOADV(tv_); } \
        LAS unsigned char* Kb_ = L + kb_ * A_KB; LAS unsigned char* Vb_ = L + A_VBASE + vbuf_ * A_VB; \
        const bool do_next_ = (t_ >= 1) && (t_ - 1 <= tmax); \
        bool do_cur_ = (t_ <= tmax); float mxc_ = 0.f; \
        if (do_cur_) { v_load_ks<NV>(Vb_, vb0, vb1, 0, va); __builtin_amdgcn_sched_barrier(0); \
                       mxc_ = rowmax32(s0, s1); if (BIAS) do_cur_ = __any(mxc_ >= m_run - 160.0f) != 0; } \
        if (do_next_ && NV == 1 && !do_cur_) { qk_load(Kb_, ka_off, kf); __builtin_amdgcn_sched_barrier(0); } \
        if (do_cur_) softmax_pv4<NV>(Vb_, wsf, s0, s1, mxc_, m_run, l_run, o, va, vb0, vb1, r32, hi, negm, started, Kb_, ka_off, kf, NV == 1 && do_next_); \
        if (do_next_) { if (NV == 2) qk_load(Kb_, ka_off, kf); qk_mma<BIAS>(Kb_, kf, qr, hi, s0, s1, negm); if (64 * (t_ - 1) + 63 > q0w) mask_tile(s0, s1, t_ - 1, qg, hi); } \
        ATT_STOREK(vbuf_); ATT_STOREV(kb_); \
        __syncthreads(); } while (0)
    for (int i = 0; i < NS; i += 2) { ATT_STEP(i); ATT_STEP(i + 1); }
#undef ATT_STEP
#undef ATT_LOADK
#undef ATT_LOADV
#undef ATT_STOREK
#undef ATT_STOREV
    const float inv = 1.0f / half_sum(l_run);
    if (hi == 0) wsf[r32] = inv;
#pragma unroll
    for (int j = 0; j < 4; ++j) { const f32x4 a = *(LAS f32x4*)(wsf + 8 * j + 4 * hi);
#pragma unroll
        for (int nv = 0; nv < NV; ++nv)
#pragma unroll
            for (int d0 = 0; d0 < 2; ++d0)
#pragma unroll
                for (int i = 0; i < 4; ++i) o[nv][d0][4 * j + i] *= a[i]; }
}

struct AttnArgs { const bf16_t* qkv; const float* cb; const bf16_t* z; bf16_t* y; float* park; const float* kn2; unsigned* counter; const float* gsub; float lam; };

__device__ __forceinline__ int lane_now() { int l; asm volatile("v_mbcnt_lo_u32_b32 %0, -1, 0\n\tv_mbcnt_hi_u32_b32 %0, -1, %0" : "=v"(l)); return l; }
__device__ __forceinline__ float xlane(float v, int src_lane) { return __int_as_float(__builtin_amdgcn_ds_bpermute(src_lane << 2, __float_as_int(v))); }
__device__ __forceinline__ void attn_phase(LAS unsigned char* L, const AttnArgs& A, const int wv  ) {
    LAS unsigned* misc = (LAS unsigned*)(L + A_MISC);
    const int xcd = blockIdx.x & 7;
    {
        const int w0 = wv, l0 = lane_now(); const float* kp = A.kn2 + (size_t)(xcd * 8 + w0) * SEQ; float mx = 0.f;
        for (int i = l0; i < SEQ; i += 64) mx = fmaxf(mx, kp[i]);
#pragma unroll
        for (int o = 1; o < 64; o <<= 1) mx = fmaxf(mx, __shfl_xor(mx, o));
        if (l0 == 0) ((LAS float*)misc)[16 + w0] = sqrtf(mx) * 1.02f;
    }
    for (int kq = 0; kq < 8; ++kq) {
    const int qx = (xcd + kq) & 7;
    for (;;) {
        __syncthreads();
        if (wv == 0 && lane_now() == 0) misc[0] = atomicAdd(A.counter + 32 * qx, 1u);
        __syncthreads();
        const unsigned idx = misc[0];
        if (idx >= 384u) break;
        const int slot = idx >> 5; const int qb = 31 - (int)(idx & 31u);
        const unsigned code = slot < 4 ? 2048u + (unsigned)((qx * 4 + slot) * 32 + qb) : (unsigned)((qx * 8 + (slot - 4)) * 32 + qb);
        const int wid = wv;
        const int q0w = qb * 256 + wid * 32;
#ifndef ATT_TEST
#define ATT_TEST 3
#endif
        if ((ATT_TEST & 1) && code < 2048u) {
            const int tid = wv * 64 + lane_now();
            const int bh = code >> 5, b = bh >> 3, h = bh & 7;
            const size_t so = (size_t)bh * SEQ * 64;
            f32x16 o[1][2];
            const float gkv = (b == xcd) ? ((LAS float*)misc)[16 + h] : -1.0f;
            attn_pass<1, true>(L, A.qkv + so, A.qkv + SB + so, A.qkv + 2 * SB + so, nullptr, A.cb + (size_t)bh * SEQ, qb, o, tid, A.kn2 + (size_t)bh * SEQ, gkv);
            {
                const int lane1 = lane_now(); const int r32e = lane1 & 31, hie = lane1 >> 5;
                LAS float* st = (LAS float*)(L + A_STAGE + wid * 8704);
#pragma unroll
                for (int d0 = 0; d0 < 2; ++d0)
#pragma unroll
                    for (int r = 0; r < 16; ++r) st[((r & 3) + 8 * (r >> 2) + 4 * hie) * 68 + 32 * d0 + r32e] = o[0][d0][r];
                const int rsub = lane1 >> 3, c8 = (lane1 & 7) * 8;
                size_t gbase = (size_t)(b * SEQ + q0w + rsub) * 512 + h * 64 + c8; asm volatile("" : "+v"(gbase));
#pragma unroll
                for (int it = 0; it < 4; ++it) {
                    const f32x4 v0 = *(LAS f32x4*)(st + (it * 8 + rsub) * 68 + c8), v1 = *(LAS f32x4*)(st + (it * 8 + rsub) * 68 + c8 + 4);
                    const u32x4 zw = *(const u32x4*)(A.z + gbase + (size_t)it * 8 * 512);
                    const f32x4 z0 = {bf_lo(zw.x), bf_hi(zw.x), bf_lo(zw.y), bf_hi(zw.y)}, z1 = {bf_lo(zw.z), bf_hi(zw.z), bf_lo(zw.w), bf_hi(zw.w)};
                    *(u32x4*)(A.y + gbase + (size_t)it * 8 * 512) = pack8(v0 * z0, v1 * z1);
                }
            }
        } else if (ATT_TEST & 2) {
            const int tid = wv * 64 + lane_now();
            const int bhd = (code - 2048u) >> 5, b = bhd >> 2, hd = bhd & 3;
            const size_t s0 = (size_t)(b * 8 + hd * 2) * SEQ * 64, s1 = s0 + (size_t)SEQ * 64;
            float* pk = A.park + (size_t)blockIdx.x * 32768 + tid * 64;
            f32x16 o[2][2];
            attn_pass<2, false>(L, A.qkv + 3 * SB + s0, A.qkv + 4 * SB + s0, A.qkv + 5 * SB + s0, A.qkv + 5 * SB + s1, nullptr, qb, o, tid, nullptr, -1.0f);
            { float* pk1 = pk; asm volatile("" : "+v"(pk1));
#pragma unroll
            for (int nv = 0; nv < 2; ++nv)
#pragma unroll
                for (int d0 = 0; d0 < 2; ++d0)
#pragma unroll
                    for (int j = 0; j < 4; ++j) { const f32x4 w = {o[nv][d0][4 * j], o[nv][d0][4 * j + 1], o[nv][d0][4 * j + 2], o[nv][d0][4 * j + 3]}; *(f32x4*)(pk1 + (nv * 2 + d0) * 16 + 4 * j) = w; }
            asm volatile("" ::: "memory"); }
            const int tid2_ = wv * 64 + lane_now();
            attn_pass<2, false>(L, A.qkv + 3 * SB + s1, A.qkv + 4 * SB + s1, A.qkv + 5 * SB + s0, A.qkv + 5 * SB + s1, nullptr, qb, o, tid2_, nullptr, -1.0f);
            f32x16 ss = f32x16{};
            const int lane2 = lane_now(), r32e = lane2 & 31, hie = lane2 >> 5;
            const float* pk2 = pk; asm volatile("" : "+v"(pk2));
#pragma unroll
            for (int nv = 0; nv < 2; ++nv)
#pragma unroll
                for (int d0 = 0; d0 < 2; ++d0) {
#pragma unroll
                    for (int j = 0; j < 4; ++j) { const f32x4 w = *(const f32x4*)(pk2 + (nv * 2 + d0) * 16 + 4 * j);
#pragma unroll
                        for (int i = 0; i < 4; ++i) { const int r = 4 * j + i; const float v = w[i] - A.lam * o[nv][d0][r]; o[nv][d0][r] = v; ss[r] += v * v; } }
                    asm volatile("" ::: "memory");
                }
#pragma unroll
            for (int r = 0; r < 16; ++r) { float s = ss[r]; s += xlane(s, lane2 ^ 1); s += xlane(s, lane2 ^ 2); s += xlane(s, lane2 ^ 4); s += xlane(s, lane2 ^ 8); s += xlane(s, lane2 ^ 16);
                ss[r] = 0.8f * __builtin_amdgcn_rsqf(s * (1.0f / 128.0f) + 1e-5f); }
            {
                LAS float* st = (LAS float*)(L + A_STAGE + wid * 8704);
                const int rsub = lane2 >> 3, c8 = (lane2 & 7) * 8;
                size_t gbase = (size_t)M * 512 + (size_t)(b * SEQ + q0w + rsub) * 512 + hd * 128 + c8; asm volatile("" : "+v"(gbase));
#pragma unroll
                for (int nv = 0; nv < 2; ++nv) {
#pragma unroll
                    for (int d0 = 0; d0 < 2; ++d0)
#pragma unroll
                        for (int r = 0; r < 16; ++r) st[((r & 3) + 8 * (r >> 2) + 4 * hie) * 68 + 32 * d0 + r32e] = o[nv][d0][r] * ss[r];
                    const f32x4 g0 = *(const f32x4*)(A.gsub + 64 * nv + c8), g1 = *(const f32x4*)(A.gsub + 64 * nv + c8 + 4);
#pragma unroll
                    for (int it = 0; it < 4; ++it) {
                        const f32x4 v0 = *(LAS f32x4*)(st + (it * 8 + rsub) * 68 + c8), v1 = *(LAS f32x4*)(st + (it * 8 + rsub) * 68 + c8 + 4);
                        const size_t gi = gbase + (size_t)it * 8 * 512 + 64 * nv;
                        const u32x4 zw = *(const u32x4*)(A.z + gi);
                        const f32x4 z0 = {bf_lo(zw.x), bf_hi(zw.x), bf_lo(zw.y), bf_hi(zw.y)}, z1 = {bf_lo(zw.z), bf_hi(zw.z), bf_lo(zw.w), bf_hi(zw.w)};
                        *(u32x4*)(A.y + gi) = pack8(v0 * g0 * z0, v1 * g1 * z1);
                    }
                    asm volatile("" ::: "memory");
                }
            }
        }
    }
    }
}

__device__ __forceinline__ int col_src(int n) {
    if (n >= 4096) return 4104 + (n - 4096);
    const int seg = n >> 9, c = n & 511;
    if (seg == 4 || seg == 5) { const int uu = c >> 6, p = c & 63, a = p >> 3, bb = p & 7; const int dim = bb < 4 ? 4 * a + bb : 32 + 4 * a + (bb - 4); return (seg == 4 ? 2056 : 2568) + uu * 64 + dim; }
    const int base = seg == 0 ? 0 : seg == 1 ? 512 : seg == 2 ? 1024 : seg == 3 ? 1544 : seg == 6 ? 3080 : 3592;
    return base + c;
}
template <bool MAP>
__device__ __forceinline__ void transpose_tile(LAS unsigned char* L, const float* __restrict__ src, int ld, int K, bf16_t* __restrict__ dst, int n0, int k0) {
    LAS float* ts = (LAS float*)L;
    const int tid = threadIdx.x, a = tid >> 6, c = tid & 63;
    const int sc = MAP ? col_src(n0 + c) : (n0 + c);
    float v[8];
#pragma unroll
    for (int p = 0; p < 8; ++p) v[p] = src[(size_t)(k0 + p * 8 + a) * ld + sc];
    __syncthreads();
#pragma unroll
    for (int p = 0; p < 8; ++p) ts[(p * 8 + a) * 65 + c] = v[p];
    __syncthreads();
#pragma unroll
    for (int p = 0; p < 8; ++p) { const int n = p * 8 + a; dst[(size_t)(n0 + n) * K + k0 + c] = bf16_1(ts[c * 65 + n]); }
}

struct P { const float* x; const float* g_pre; const float* w_in; const float* b_forget; const float* lq1; const float* lk1; const float* lq2; const float* lk2;
           const float* g_subln; const float* w_branch; const float* w_out; const float* g_post; float* out; unsigned char* ws; };

__device__ __forceinline__ void p0_prologue(LAS unsigned char* L, const P& p) {
    const int tid = threadIdx.x, lane = tid & 63, wid = tid >> 6;
    const int gtid = blockIdx.x * 512 + tid, gsz = gridDim.x * 512;
    unsigned char* ws = p.ws;
    float* ssq = (float*)(ws + WS_SSQ);
    for (int i = gtid; i < M; i += gsz) ssq[i] = 0.f;
    { float* kn2 = (float*)(ws + WS_KN2); for (int i = gtid; i < 64 * SEQ; i += gsz) kn2[i] = 0.f; }
    if (gtid < 8) ((unsigned*)(ws + WS_CTL))[32 * gtid] = 0u;
    if (gtid == 0) {
        float d1 = 0.f, d2 = 0.f;
        for (int i = 0; i < 64; ++i) { d1 += p.lq1[i] * p.lk1[i]; d2 += p.lq2[i] * p.lk2[i]; }
        ((float*)(ws + WS_CTL))[512] = expf(d1) - expf(d2) + 0.2f; }
    if (gtid < NITEMS) {
        unsigned* items = (unsigned*)(ws + WS_ITEMS); int rank; unsigned code;
        if (gtid < 1024) { const int qb = gtid >> 5, j = gtid & 31, c = 3 * (qb + 1); rank = 32 * (31 - qb) + 64 * (32 - c > 0 ? 32 - c : 0) + j; code = 2048u + (unsigned)(j * 32 + qb); }
        else { const int i2 = gtid - 1024, qb = i2 >> 6, j = i2 & 63, c = qb + 1; rank = 32 * (33 - (c + 2) / 3) + 64 * (32 - c) + j; code = (unsigned)(j * 32 + qb); }
        items[rank] = code;
    }
    {
        float* cs = (float*)(ws + WS_COS); float* sn = (float*)(ws + WS_SIN);
        for (int i = gtid; i < SEQ * 32; i += gsz) { const int s = i >> 5, f = i & 31;
            const double invf = exp2(-(double)f * (13.287712379549449 / 32.0));
            double rev = (double)s * invf * 0.15915494309189535; rev -= floor(rev);
            const float rf = (float)rev; cs[i] = __builtin_amdgcn_cosf(rf); sn[i] = __builtin_amdgcn_sinf(rf); }
    }
    for (int tt = blockIdx.x; tt < 2048; tt += gridDim.x) {
        if (tt < 1536) transpose_tile<true>(L, p.w_in, NIN, DM, (bf16_t*)(ws + WS_BT1), (tt >> 4) << 6, (tt & 15) << 6);
        else if (tt < 1792) { const int u = tt - 1536, br = u >> 7, v = u & 127;
            transpose_tile<false>(L, p.w_branch + (size_t)br * 512 * DM, DM, 512, (bf16_t*)(ws + WS_BT3A) + (size_t)br * DM * 512, (v >> 3) << 6, (v & 7) << 6); }
        else { const int u = tt - 1792; transpose_tile<false>(L, p.w_out, DM, DM, (bf16_t*)(ws + WS_BT3B), (u >> 4) << 6, (u & 15) << 6); }
    }
    {
        f32x4 gp[4]; float wf[4][4][8];
#pragma unroll
        for (int j = 0; j < 4; ++j) { gp[j] = *(const f32x4*)(p.g_pre + 4 * lane + 256 * j);
#pragma unroll
            for (int i = 0; i < 4; ++i) { const float* wp = p.w_in + (size_t)(4 * lane + 256 * j + i) * NIN + 1536; const f32x4 w0 = *(const f32x4*)wp, w1 = *(const f32x4*)(wp + 4);
                wf[j][i][0] = w0[0]; wf[j][i][1] = w0[1]; wf[j][i][2] = w0[2]; wf[j][i][3] = w0[3]; wf[j][i][4] = w1[0]; wf[j][i][5] = w1[1]; wf[j][i][6] = w1[2]; wf[j][i][7] = w1[3]; } }
        const int hh = (lane & 1) * 4 + ((lane >> 1) & 1) * 2 + ((lane >> 2) & 1);
        const float bfg = p.b_forget[hh];
        bf16_t* hb = (bf16_t*)(ws + WS_H); float* logf_ = (float*)(ws + WS_LOGF);
        const int rstep = gridDim.x * 8;
        int row = blockIdx.x * 8 + wid;
        f32x4 xv[4], xm[4], xn[4];
#pragma unroll
        for (int j = 0; j < 4; ++j) xv[j] = __builtin_nontemporal_load((const f32x4*)(p.x + (size_t)row * DM + 4 * lane + 256 * j));
        { const int r1 = row + rstep < M ? row + rstep : row;
#pragma unroll
          for (int j = 0; j < 4; ++j) xm[j] = __builtin_nontemporal_load((const f32x4*)(p.x + (size_t)r1 * DM + 4 * lane + 256 * j)); }
        for (; row < M; row += rstep) {
            const int rnext = row + 2 * rstep < M ? row + 2 * rstep : row;
#pragma unroll
            for (int j = 0; j < 4; ++j) xn[j] = __builtin_nontemporal_load((const f32x4*)(p.x + (size_t)rnext * DM + 4 * lane + 256 * j));
            float ss = 0.f;
#pragma unroll
            for (int j = 0; j < 4; ++j) ss += (xv[j][0] * xv[j][0] + xv[j][1] * xv[j][1]) + (xv[j][2] * xv[j][2] + xv[j][3] * xv[j][3]);
#pragma unroll
            for (int o = 1; o < 64; o <<= 1) ss += __shfl_xor(ss, o);
            const float rs = 1.0f / sqrtf(ss * (1.0f / 1024.0f) + 1e-6f);
            float fa[8] = {0.f, 0.f, 0.f, 0.f, 0.f, 0.f, 0.f, 0.f};
#pragma unroll
            for (int j = 0; j < 4; ++j) { const f32x4 hv = xv[j] * rs * gp[j];
                u32x2 w; w.x = pk_bf16(hv[0], hv[1]); w.y = pk_bf16(hv[2], hv[3]); *(u32x2*)(hb + (size_t)row * DM + 4 * lane + 256 * j) = w;
#pragma unroll
                for (int i = 0; i < 4; ++i)
#pragma unroll
                    for (int e = 0; e < 8; ++e) fa[e] += hv[i] * wf[j][i][e]; }
            float g4[4], g2[2], g1;
            { const bool up = (lane & 1) != 0;
#pragma unroll
              for (int k = 0; k < 4; ++k) { const float snd = up ? fa[k] : fa[k + 4]; const float rcv = __shfl_xor(snd, 1); g4[k] = (up ? fa[k + 4] : fa[k]) + rcv; } }
            { const bool up = (lane & 2) != 0;
#pragma unroll
              for (int k = 0; k < 2; ++k) { const float snd = up ? g4[k] : g4[k + 2]; const float rcv = __shfl_xor(snd, 2); g2[k] = (up ? g4[k + 2] : g4[k]) + rcv; } }
            { const bool up = (lane & 4) != 0; const float snd = up ? g2[0] : g2[1]; const float rcv = __shfl_xor(snd, 4); g1 = (up ? g2[1] : g2[0]) + rcv; }
            g1 += __shfl_xor(g1, 8); g1 += __shfl_xor(g1, 16); g1 += __shfl_xor(g1, 32);
            if (lane < 8) { const float zf = g1 + bfg; const float ls = fminf(zf, 0.f) - log1pf(expf(-fabsf(zf)));
                logf_[(size_t)((row >> 13) * 8 + hh) * SEQ + (row & (SEQ - 1))] = ls; }
#pragma unroll
            for (int j = 0; j < 4; ++j) { xv[j] = xm[j]; xm[j] = xn[j]; }
        }
    }
}

__device__ __forceinline__ void cumsum_seq(LAS unsigned char* L, const float* __restrict__ lf, float* __restrict__ cb, const int wv) {
    const int lane = lane_now(), wid = wv, tid = wv * 64 + lane;
    LAS float* wt = (LAS float*)L;
    f32x4 v[4]; float run = 0.f;
#pragma unroll
    for (int j = 0; j < 4; ++j) { v[j] = *(const f32x4*)(lf + tid * 16 + 4 * j);
#pragma unroll
        for (int i = 0; i < 4; ++i) { run += v[j][i]; v[j][i] = run; } }
    float sc = run;
#pragma unroll
    for (int o = 1; o < 64; o <<= 1) { const float n = __shfl_up(sc, o); if (lane >= o) sc += n; }
    __syncthreads();
    if (lane == 63) wt[wid] = sc;
    __syncthreads();
    float pre = sc - run;
    for (int w = 0; w < wid; ++w) pre += wt[w];
#pragma unroll
    for (int j = 0; j < 4; ++j) { f32x4 r;
#pragma unroll
        for (int i = 0; i < 4; ++i) r[i] = -(pre + v[j][i]) * LOG2E;
        *(f32x4*)(cb + tid * 16 + 4 * j) = r; }
    __syncthreads();
}

__global__ void __launch_bounds__(512) fwd_megakernel(P p) {
    extern __shared__ __attribute__((aligned(16))) unsigned char lds_raw[];
    LAS unsigned char* L = (LAS unsigned char*)lds_raw;
    cg::grid_group grid = cg::this_grid();
    unsigned char* ws = p.ws;
    const int G = gridDim.x, c = blockIdx.x;
    const int wv = __builtin_amdgcn_readfirstlane(threadIdx.x >> 6);
    bf16_t* qkv = (bf16_t*)(ws + WS_QKV); bf16_t* zbuf = (bf16_t*)(ws + WS_Z); bf16_t* gbuf = (bf16_t*)(ws + WS_G);

#ifndef PHM
#define PHM 63
#endif
    if (PHM & 1) p0_prologue(L, p);
    grid.sync();

    if ((PHM & 2) && c < 64) cumsum_seq(L, (const float*)(ws + WS_LOGF) + (size_t)c * SEQ, (float*)(ws + WS_CB) + (size_t)c * SEQ, wv);
    if (PHM & 2) {
        pg8::Gemm g{(const bf16_t*)(ws + WS_H), (const bf16_t*)(ws + WS_BT1), M, N1, DM}; pg8::StaticOrder S; S.init(M, N1, G, c);
        Epi1 E{qkv, zbuf, gbuf, (const float*)(ws + WS_COS), (const float*)(ws + WS_SIN), (float*)(ws + WS_KN2)};
        pg8::gemm_phase<Epi1, pg8::StaticOrder, true, true>(L, g, S, E, wv);
    }
    grid.sync();

    if (PHM & 4) {
        const float lam = ((const float*)(ws + WS_CTL))[512];
        AttnArgs A{qkv, (const float*)(ws + WS_CB), zbuf, (bf16_t*)(ws + WS_Y), (float*)(ws + WS_PARK), (const float*)(ws + WS_KN2), (unsigned*)(ws + WS_CTL), p.g_subln, lam};
        attn_phase(L, A, wv);
    }
    grid.sync();

    if (PHM & 8) {
        pg8::Gemm g{(const bf16_t*)(ws + WS_Y), (const bf16_t*)(ws + WS_BT3A), 2 * M, 2 * DM, 512}; Sched3a S; S.so.init(M, DM, G, c);
        Epi3a E{gbuf, (bf16_t*)(ws + WS_T), (bf16_t*)(ws + WS_MERGED)};
        pg8::gemm_phase<Epi3a, Sched3a, true, true>(L, g, S, E, wv);
    }
    grid.sync();

    if (PHM & 16) {
        pg8::Gemm g{(const bf16_t*)(ws + WS_MERGED), (const bf16_t*)(ws + WS_BT3B), M, DM, DM}; pg8::StaticOrder S; S.init(M, DM, G, c);
        Epi3b E{(bf16_t*)(ws + WS_Z), (float*)(ws + WS_SSQ)};
        pg8::gemm_phase<Epi3b, pg8::StaticOrder, true, true>(L, g, S, E, wv);
    }
    grid.sync();

    if (PHM & 32) {
        const float* ssq = (const float*)(ws + WS_SSQ);
        const int t4_ = wv * 64 + lane_now();
        const int gtid = c * 512 + t4_, gsz = G * 512;
        for (int i = gtid; i < M * 256; i += gsz) {
            const int row = i >> 8, c4 = i & 255;
            const u32x2 yw = *(const u32x2*)((const bf16_t*)(ws + WS_Z) + (size_t)i * 4); const f32x4 yv = {bf_lo(yw.x), bf_hi(yw.x), bf_lo(yw.y), bf_hi(yw.y)};
            const f32x4 xv = *(const f32x4*)(p.x + (size_t)i * 4), gv = *(const f32x4*)(p.g_post + c4 * 4);
            const float rs = 1.0f / sqrtf(ssq[row] * (1.0f / 1024.0f) + 1e-6f);
            *(f32x4*)(p.out + (size_t)i * 4) = xv + yv * rs * gv;
        }
    }
}
}

extern "C" void kernel_launch(void* const* d_in, const int* in_sizes, int n_in, void* d_out, int out_size, void* d_ws, size_t ws_size, hipStream_t stream) {
    static int grid = 0;
    if (grid == 0) {
        if (n_in != 12 || ws_size < mk::WS_END) { fprintf(stderr, "kernel_launch: unexpected n_in %d / ws_size %zu\n", n_in, ws_size); grid = -1; return; }
        int dev = 0, cus = 0, per_cu = 0;
        hipGetDevice(&dev); hipDeviceGetAttribute(&cus, hipDeviceAttributeMultiprocessorCount, dev);
        if (hipFuncSetAttribute((const void*)mk::fwd_megakernel, hipFuncAttributeMaxDynamicSharedMemorySize, mk::LDS_BYTES) != hipSuccess) { fprintf(stderr, "kernel_launch: hipFuncSetAttribute failed\n"); grid = -1; return; }
        if (hipOccupancyMaxActiveBlocksPerMultiprocessor(&per_cu, (const void*)mk::fwd_megakernel, 512, mk::LDS_BYTES) != hipSuccess || per_cu < 1) { fprintf(stderr, "kernel_launch: occupancy query says %d\n", per_cu); per_cu = 1; }
        (void)hipGetLastError();
        grid = cus;
    }
    if (grid < 0) return;
    mk::P p{};
    p.x = (const float*)d_in[0]; p.g_pre = (const float*)d_in[1]; p.w_in = (const float*)d_in[2]; p.b_forget = (const float*)d_in[3];
    p.lq1 = (const float*)d_in[4]; p.lk1 = (const float*)d_in[5]; p.lq2 = (const float*)d_in[6]; p.lk2 = (const float*)d_in[7];
    p.g_subln = (const float*)d_in[8]; p.w_branch = (const float*)d_in[9]; p.w_out = (const float*)d_in[10]; p.g_post = (const float*)d_in[11];
    p.out = (float*)d_out; p.ws = (unsigned char*)d_ws;
    void* args[] = {&p};
    hipError_t e = hipLaunchCooperativeKernel((const void*)mk::fwd_megakernel, dim3(grid), dim3(512), args, mk::LDS_BYTES, stream);
    if (e != hipSuccess) fprintf(stderr, "cooperative launch failed: %s (grid %d)\n", hipGetErrorString(e), grid);
}
```

```cpp
#include <hip/hip_runtime.h>
#include <hip/hip_cooperative_groups.h>
#include <cstdio>
#include <cstdint>
namespace cg = cooperative_groups;
namespace pg8 {
#define PG8_LAS __attribute__((address_space(3)))
typedef unsigned short bf16_t;
typedef short bf16x8 __attribute__((ext_vector_type(8)));
typedef float f32x4 __attribute__((ext_vector_type(4)));
typedef unsigned u32x4 __attribute__((ext_vector_type(4)));
constexpr int BM = 256, BK = 64, HALF = 128, HTB = HALF * BK * 2  , STAGE_BYTES = 8 * HTB, NXCD = 8, WGM = 4;

__host__ __device__ __forceinline__ int lds_byte(int r, int c) { const int st = (r >> 4) * 2 + (c >> 5), rr = r & 15, cc = c & 31, ob = rr * 64 + cc * 2; return st * 1024 + (ob ^ (((ob >> 9) & 1) << 5)); }
__host__ __device__ __forceinline__ void stage_rc(int b, int& R, int& C) { const int st = b / 1024, sb = b % 1024, swz = sb ^ (((sb >> 9) & 1) << 5); R = (st >> 1) * 16 + swz / 64; C = (st & 1) * 32 + (swz % 64) / 2; }
__host__ __device__ __forceinline__ int perm32(int rho) { const int n = rho >> 4, i = rho & 15; return 8 * (i >> 2) + 4 * n + (i & 3); }

struct Unit { int pm, pn; };
struct Gemm { const bf16_t* A; const bf16_t* Bt; int M, N, K; };

struct StaticOrder {
    int nM, nN, nwg, G, c;
    __host__ __device__ void init(int M, int N, int G_, int c_) { nM = M / BM; nN = N / BM; nwg = nM * nN; G = G_; c = c_; }
    __host__ __device__ bool next(int i, Unit& u) const {
        const long L = (long)i * G + c; if (L >= nwg) return false;
        int wgid = (int)L; { const int q = nwg / NXCD, r = nwg % NXCD, xcd = wgid % NXCD, off = wgid / NXCD; wgid = (xcd < r ? xcd * (q + 1) : r * (q + 1) + (xcd - r) * q) + off; }
        const int nig = WGM * nN, gid = wgid / nig, fm = gid * WGM, gsz = (nM - fm) < WGM ? (nM - fm) : WGM;
        u.pm = fm + ((wgid % nig) % gsz); u.pn = (wgid % nig) / gsz; return true;
    }
    __device__ __forceinline__ void a_ready(const Unit&) const {}
    __device__ __forceinline__ void done(const Unit&) const {}
};

__device__ __forceinline__ unsigned cvt_pk_bf16(float lo, float hi) { unsigned r; asm volatile("v_cvt_pk_bf16_f32 %0, %1, %2" : "=v"(r) : "v"(lo), "v"(hi)); return r; }
typedef float f32x2 __attribute__((ext_vector_type(2)));
__device__ __forceinline__ f32x2 gelu_pk(f32x2 v) {
    const f32x2 av = __builtin_elementwise_abs(v), d = av * 0.2316418882f + 1.0f;
    f32x2 t; t.x = __builtin_amdgcn_rcpf(d.x); t.y = __builtin_amdgcn_rcpf(d.y);
    f32x2 q = t * 0.5307027145f + (-0.7265760135f); q = q * t + 0.7107068705f; q = q * t + (-0.142248368f); q = q * t + 0.127414796f; q = q * t;
    const f32x2 s = (v * v) * (-0.72134752044f);
    f32x2 e; e.x = __builtin_amdgcn_exp2f(s.x); e.y = __builtin_amdgcn_exp2f(s.y);
    const f32x2 m = v * (q * e), r = v - m;
    f32x2 o; o.x = v.x < 0.f ? m.x : r.x; o.y = v.y < 0.f ? m.y : r.y; return o;
}

template <int ACT  > struct EpiBf16 {
    static constexpr bool PERM = true, AFTER_DRAIN = false; static_assert(ACT == 0 || ACT == 1, "EpiBf16: ACT is 0 (none) or 1 (gelu_pk)");
    bf16_t* O; int ldc; const float* bias; int split_cols; size_t split_stride; float scale0;
    __device__ __forceinline__ void operator()(const f32x4 (&acc)[2][2][4][2], const Unit& u, int wr, int wc, int fr, int fq) const {
        const int row0 = u.pm * BM + wr * 64 + fr; int colt = u.pn * BM; bf16_t* base = O;
        float sc = 1.f; if (split_cols) { const int t = colt / split_cols; base += (size_t)t * split_stride; colt -= t * split_cols; if (t == 0) sc = scale0; }
        const int col0 = colt + wc * 32 + 8 * fq, bcol0 = u.pn * BM + wc * 32 + 8 * fq;
        f32x4 bv[2][2];
#pragma unroll
        for (int bj = 0; bj < 2; ++bj)
#pragma unroll
            for (int n = 0; n < 2; ++n) bv[bj][n] = bias ? *(const f32x4*)(bias + bcol0 + bj * HALF + 4 * n) : (f32x4){0.f, 0.f, 0.f, 0.f};
#pragma unroll
        for (int ai = 0; ai < 2; ++ai)
#pragma unroll
            for (int m = 0; m < 4; ++m) { bf16_t* rowp = base + (size_t)(row0 + ai * HALF + m * 16) * ldc + col0;
#pragma unroll
                for (int bj = 0; bj < 2; ++bj) { f32x4 v0 = acc[ai][bj][m][0] + bv[bj][0], v1 = acc[ai][bj][m][1] + bv[bj][1];
                    if (ACT == 1) { f32x2 a = gelu_pk((f32x2){v0[0], v0[1]}), b = gelu_pk((f32x2){v0[2], v0[3]}), c = gelu_pk((f32x2){v1[0], v1[1]}), d = gelu_pk((f32x2){v1[2], v1[3]});
                        v0 = (f32x4){a.x, a.y, b.x, b.y}; v1 = (f32x4){c.x, c.y, d.x, d.y}; }
                    v0 = v0 * sc; v1 = v1 * sc; u32x4 w; w.x = cvt_pk_bf16(v0[0], v0[1]); w.y = cvt_pk_bf16(v0[2], v0[3]); w.z = cvt_pk_bf16(v1[0], v1[1]); w.w = cvt_pk_bf16(v1[2], v1[3]);
                    *(u32x4*)(rowp + bj * HALF) = w; } }
    }
};

template <class Epi, class Sched, bool ALIGN_EPI = false, bool SP2 = false>
__device__ __forceinline__ void gemm_phase(PG8_LAS unsigned char* lds, const Gemm g, const Sched& S, const Epi& E, const int wv  ) {
    int lane_; asm volatile("v_mbcnt_lo_u32_b32 %0, -1, 0\n\tv_mbcnt_hi_u32_b32 %0, -1, %0" : "=v"(lane_));
    const int tid_ = wv * 64 + lane_;
    const int tid = tid_, wid = __builtin_amdgcn_readfirstlane(tid >> 6), lane = tid & 63, wr = wid >> 2, wc = wid & 3, fr = lane & 15, fq = lane >> 4;
    const int K = g.K, nt = K / BK;
    unsigned voffA[2], voffB[2];
#pragma unroll
    for (int i = 0; i < 2; ++i) { int R, C; stage_rc(tid * 16 + i * 8192, R, C); const int Rb = Epi::PERM ? ((R & ~31) + perm32(R & 31)) : R;
        voffA[i] = (unsigned)(R * K + C) * 2u; voffB[i] = (unsigned)(Rb * K + C) * 2u; }
    const size_t kstep = (size_t)(BK * 2);
    const size_t hstep = (size_t)HALF * K * 2;
    const size_t tstep = 2 * hstep;
    const unsigned ldsw = (unsigned)wid * 1024u;
    const int aoff = lds_byte(wr * 64 + fr, fq * 8), boff = lds_byte(wc * 32 + fr, fq * 8);
#define PG8_SA(b, h) (((b) * 2 + (h)) * HTB)
#define PG8_SB(b, h) ((4 + (b) * 2 + (h)) * HTB)
#define PG8_STAGE(bufoff, gbase, voff) do { _Pragma("unroll") for (int _i = 0; _i < 2; ++_i) \
        __builtin_amdgcn_global_load_lds((const unsigned*)((const char*)(gbase) + (voff)[_i]), (PG8_LAS unsigned*)(lds + (bufoff) + ldsw + _i * 8192), 16, 0, 0); } while (0)
#define PG8_LDA(dst, b, h) do { _Pragma("unroll") for (int m = 0; m < 4; ++m) _Pragma("unroll") for (int k = 0; k < 2; ++k) dst[m][k] = *(const PG8_LAS bf16x8*)(lds + PG8_SA(b, h) + aoff + m * 2048 + k * 1024); } while (0)
#define PG8_LDB(dst, b, h) do { _Pragma("unroll") for (int n = 0; n < 2; ++n) _Pragma("unroll") for (int k = 0; k < 2; ++k) dst[n][k] = *(const PG8_LAS bf16x8*)(lds + PG8_SB(b, h) + boff + n * 2048 + k * 1024); } while (0)
#define PG8_MMA(ai, bj, At, Bt) do { __builtin_amdgcn_s_setprio(1); _Pragma("unroll") for (int m = 0; m < 4; ++m) _Pragma("unroll") for (int n = 0; n < 2; ++n) _Pragma("unroll") for (int k = 0; k < 2; ++k) \
        acc[ai][bj][m][n] = __builtin_amdgcn_mfma_f32_16x16x32_bf16(Bt[n][k], At[m][k], acc[ai][bj][m][n], 0, 0, 0); __builtin_amdgcn_s_setprio(0); } while (0)
#define PG8_WAIT_V(n) asm volatile("s_waitcnt vmcnt(" #n ")" ::: "memory")
#define PG8_WAIT_L(n) asm volatile("s_waitcnt lgkmcnt(" #n ")" ::: "memory")
#define PG8_BAR __builtin_amdgcn_s_barrier()
#define PG8_SCHED __builtin_amdgcn_sched_barrier(0)
    Unit cur, nxt; int ui = 0;
    if (!S.next(0, cur)) return;
    f32x4 acc[2][2][4][2];
#pragma unroll
    for (int a = 0; a < 2; ++a)
#pragma unroll
        for (int b = 0; b < 2; ++b)
#pragma unroll
            for (int m = 0; m < 4; ++m)
#pragma unroll
                for (int n = 0; n < 2; ++n) acc[a][b][m][n] = (f32x4){0.f, 0.f, 0.f, 0.f};
    bf16x8 At[4][2], B0[2][2], B1[2][2];
    const char* cA = (const char*)g.A + (size_t)cur.pm * tstep; const char* cB = (const char*)g.Bt + (size_t)cur.pn * tstep;
    S.a_ready(cur);
    if constexpr (SP2) {
        PG8_STAGE(PG8_SB(0, 0), cB, voffB); PG8_STAGE(PG8_SB(0, 1), cB + hstep, voffB); PG8_STAGE(PG8_SA(0, 0), cA, voffA); PG8_STAGE(PG8_SA(0, 1), cA + hstep, voffA);
        if (wr == 1) PG8_BAR;
        PG8_WAIT_V(2); PG8_BAR;
        PG8_STAGE(PG8_SB(1, 0), cB + kstep, voffB); PG8_STAGE(PG8_SA(1, 0), cA + kstep, voffA); PG8_STAGE(PG8_SB(1, 1), cB + hstep + kstep, voffB);
        PG8_WAIT_V(6); PG8_BAR;
    } else {
        PG8_STAGE(PG8_SB(0, 0), cB, voffB); PG8_STAGE(PG8_SA(0, 0), cA, voffA); PG8_STAGE(PG8_SB(0, 1), cB + hstep, voffB); PG8_STAGE(PG8_SA(0, 1), cA + hstep, voffA);
        if (wr == 1) PG8_BAR;
        PG8_WAIT_V(4); PG8_BAR;
        PG8_STAGE(PG8_SB(1, 0), cB + kstep, voffB); PG8_STAGE(PG8_SA(1, 0), cA + kstep, voffA); PG8_STAGE(PG8_SB(1, 1), cB + hstep + kstep, voffB);
        PG8_WAIT_V(6); PG8_BAR;
    }
    for (;;) {
        const bool has_next = S.next(ui + 1, nxt);
        const char* nA = has_next ? (const char*)g.A + (size_t)nxt.pm * tstep : cA; const char* nB = has_next ? (const char*)g.Bt + (size_t)nxt.pn * tstep : cB;
        for (int t = 0; t < nt; t += 2) {
            const bool last = (t == nt - 2);
            const char* a1 = cA + (size_t)(t + 1) * kstep;
            const char* a2 = last ? nA : cA + (size_t)(t + 2) * kstep; const char* b2 = last ? nB : cB + (size_t)(t + 2) * kstep;
            const char* a3 = a2 + kstep; const char* b3 = b2 + kstep;
            if (last && has_next) S.a_ready(nxt);
            if constexpr (SP2) {
            PG8_LDB(B0, 0, 0); PG8_LDB(B1, 0, 1); PG8_SCHED; PG8_LDA(At, 0, 0); PG8_STAGE(PG8_SA(1, 1), a1 + hstep, voffA);
            PG8_WAIT_V(8); PG8_WAIT_L(0); PG8_BAR; PG8_MMA(0, 0, At, B0); PG8_MMA(0, 1, At, B1); PG8_BAR; PG8_SCHED;
            PG8_LDA(At, 0, 1); PG8_STAGE(PG8_SB(0, 0), b2, voffB); PG8_STAGE(PG8_SB(0, 1), b2 + hstep, voffB); PG8_STAGE(PG8_SA(0, 0), a2, voffA);
            PG8_WAIT_V(8); PG8_WAIT_L(0); PG8_BAR; PG8_MMA(1, 0, At, B0); PG8_MMA(1, 1, At, B1); PG8_BAR; PG8_SCHED;
            PG8_LDB(B0, 1, 0); PG8_LDB(B1, 1, 1); PG8_SCHED; PG8_LDA(At, 1, 0); PG8_STAGE(PG8_SA(0, 1), a2 + hstep, voffA);
            PG8_WAIT_V(8); PG8_WAIT_L(0); PG8_BAR; PG8_MMA(0, 0, At, B0); PG8_MMA(0, 1, At, B1); PG8_BAR; PG8_SCHED;
            PG8_LDA(At, 1, 1); PG8_STAGE(PG8_SB(1, 0), b3, voffB); PG8_STAGE(PG8_SB(1, 1), b3 + hstep, voffB); PG8_STAGE(PG8_SA(1, 0), a3, voffA);
            PG8_WAIT_V(8); PG8_WAIT_L(0); PG8_BAR; PG8_MMA(1, 0, At, B0); PG8_MMA(1, 1, At, B1); PG8_BAR; PG8_SCHED;
            } else {
            PG8_LDB(B0, 0, 0); PG8_SCHED; PG8_LDA(At, 0, 0); PG8_STAGE(PG8_SA(1, 1), a1 + hstep, voffA);
            PG8_WAIT_L(8); PG8_BAR; PG8_WAIT_L(0); PG8_MMA(0, 0, At, B0); PG8_BAR; PG8_SCHED;
            PG8_LDB(B1, 0, 1); PG8_STAGE(PG8_SB(0, 0), b2, voffB);
            PG8_BAR; PG8_WAIT_L(0); PG8_MMA(0, 1, At, B1); PG8_BAR;
            PG8_LDA(At, 0, 1); PG8_STAGE(PG8_SA(0, 0), a2, voffA);
            PG8_BAR; PG8_WAIT_L(0); PG8_MMA(1, 0, At, B0); PG8_BAR; PG8_SCHED;
            PG8_STAGE(PG8_SB(0, 1), b2 + hstep, voffB);
            PG8_WAIT_V(6); PG8_BAR; PG8_MMA(1, 1, At, B1); PG8_BAR;
            PG8_LDB(B0, 1, 0); PG8_SCHED; PG8_LDA(At, 1, 0); PG8_STAGE(PG8_SA(0, 1), a2 + hstep, voffA);
            PG8_WAIT_L(8); PG8_BAR; PG8_WAIT_L(0); PG8_MMA(0, 0, At, B0); PG8_BAR; PG8_SCHED;
            PG8_LDB(B1, 1, 1); PG8_STAGE(PG8_SB(1, 0), b3, voffB);
            PG8_BAR; PG8_WAIT_L(0); PG8_MMA(0, 1, At, B1); PG8_BAR;
            PG8_LDA(At, 1, 1); PG8_STAGE(PG8_SA(1, 0), a3, voffA);
            PG8_BAR; PG8_WAIT_L(0); PG8_MMA(1, 0, At, B0); PG8_BAR; PG8_SCHED;
            PG8_STAGE(PG8_SB(1, 1), b3 + hstep, voffB);
            PG8_WAIT_V(6); PG8_BAR; PG8_MMA(1, 1, At, B1); PG8_BAR;
            }
        }
        if constexpr (ALIGN_EPI) { if (wr == 0) PG8_BAR; }
        if constexpr (!Epi::AFTER_DRAIN) { E(acc, cur, wr, wc, fr, fq); S.done(cur); }
        if (!has_next) break;
#pragma unroll
        for (int a = 0; a < 2; ++a)
#pragma unroll
            for (int b = 0; b < 2; ++b)
#pragma unroll
                for (int m = 0; m < 4; ++m)
#pragma unroll
                    for (int n = 0; n < 2; ++n) acc[a][b][m][n] = (f32x4){0.f, 0.f, 0.f, 0.f};
        cur = nxt; cA = nA; cB = nB; ++ui;
        if constexpr (ALIGN_EPI) { if (wr == 1) PG8_BAR; }
    }
    PG8_WAIT_V(0);
    if constexpr (!ALIGN_EPI) { if (wr == 0) PG8_BAR; }
    PG8_BAR;
    if constexpr (Epi::AFTER_DRAIN) { E.fused(acc, cur, wr, wc, fr, fq, lds, wid, lane); S.done(cur); }
#undef PG8_SA
#undef PG8_SB
#undef PG8_STAGE
#undef PG8_LDA
#undef PG8_LDB
#undef PG8_MMA
#undef PG8_WAIT_V
#undef PG8_WAIT_L
#undef PG8_BAR
#undef PG8_SCHED
}
}

#define LAS __attribute__((address_space(3)))
namespace mk {
using pg8::bf16_t; using pg8::f32x4; using pg8::u32x4; using pg8::Unit;
typedef short bf16x8 __attribute__((ext_vector_type(8)));
typedef short s16x4 __attribute__((ext_vector_type(4)));
typedef float f32x16 __attribute__((ext_vector_type(16)));
typedef unsigned u32x2 __attribute__((ext_vector_type(2)));

constexpr int M = 65536, DM = 1024, SEQ = 8192, NBATCH = 8, NIN = 6152, N1 = 6144, NITEMS = 3072;
constexpr size_t MiB = (size_t)1 << 20;
constexpr size_t WS_CTL = 0, WS_BT1 = 1 * MiB, WS_BT3A = 13 * MiB, WS_BT3B = 15 * MiB, WS_COS = 17 * MiB, WS_SIN = 18 * MiB, WS_LOGF = 19 * MiB, WS_CB = 21 * MiB,
                 WS_SSQ = 23 * MiB, WS_PARK = 24 * MiB, WS_ITEMS = 56 * MiB, WS_KN2 = 57 * MiB, WS_G = 64 * MiB, WS_QKV = 320 * MiB, WS_Z = 704 * MiB, WS_H = 832 * MiB, WS_Y = WS_H,
                 WS_T = 320 * MiB, WS_MERGED = 576 * MiB, WS_END = 960 * MiB;
constexpr size_t SB = (size_t)NBATCH * 8 * SEQ * 64;
constexpr float C2 = 0.125f * 1.4426950408889634f;
constexpr float LOG2E = 1.4426950408889634f;
constexpr int LDS_BYTES = 131072 + 256;

__device__ __forceinline__ unsigned pk_bf16(float lo, float hi) {
    typedef float f32x2_t __attribute__((ext_vector_type(2))); typedef __bf16 bf16x2_t __attribute__((ext_vector_type(2)));
    f32x2_t v = {lo, hi}; bf16x2_t b = __builtin_convertvector(v, bf16x2_t); return __builtin_bit_cast(unsigned, b); }
__device__ __forceinline__ bf16_t bf16_1(float v) { return (bf16_t)(pk_bf16(v, 0.f) & 0xffffu); }
__device__ __forceinline__ float bf_lo(unsigned w) { return __uint_as_float(w << 16); }
__device__ __forceinline__ float bf_hi(unsigned w) { return __uint_as_float(w & 0xffff0000u); }
__device__ __forceinline__ float bf1(bf16_t v) { return __uint_as_float((unsigned)v << 16); }
__device__ __forceinline__ float sigmoid_(float v) { return __builtin_amdgcn_rcpf(1.f + __expf(-v)); }
__device__ __forceinline__ float silu_(float v) { return v * sigmoid_(v); }
__device__ __forceinline__ u32x4 pack8(const f32x4 a, const f32x4 b) { u32x4 w; w.x = pk_bf16(a[0], a[1]); w.y = pk_bf16(a[2], a[3]); w.z = pk_bf16(b[0], b[1]); w.w = pk_bf16(b[2], b[3]); return w; }

struct Epi1 {
    static constexpr bool PERM = true, AFTER_DRAIN = false;
    bf16_t* qkv; bf16_t* z; bf16_t* g; const float* cs; const float* sn; float* kn2;
    __device__ __forceinline__ void operator()(const f32x4 (&acc)[2][2][4][2], const Unit& u, int wr, int wc, int fr, int fq) const {
        const int pn = u.pn; const int row0 = u.pm * 256 + wr * 64 + fr; const int ct = wc * 32 + 8 * fq;
        if (pn >= 16) {
#pragma unroll
            for (int ai = 0; ai < 2; ++ai)
#pragma unroll
                for (int m = 0; m < 4; ++m) { const int row = row0 + ai * 128 + m * 16; bf16_t* rp = g + (size_t)row * 2048 + (pn - 16) * 256 + ct;
#pragma unroll
                    for (int bj = 0; bj < 2; ++bj) { f32x4 v0 = acc[ai][bj][m][0], v1 = acc[ai][bj][m][1];
#pragma unroll
                        for (int i = 0; i < 4; ++i) { v0[i] = sigmoid_(v0[i]); v1[i] = sigmoid_(v1[i]); }
                        *(u32x4*)(rp + bj * 128) = pack8(v0, v1); } }
        } else if ((pn & 7) >= 6) {
            bf16_t* zz = z + (pn >= 8 ? (size_t)M * 512 : (size_t)0);
#pragma unroll
            for (int ai = 0; ai < 2; ++ai)
#pragma unroll
                for (int m = 0; m < 4; ++m) { const int row = row0 + ai * 128 + m * 16; bf16_t* rp = zz + (size_t)row * 512 + (pn & 1) * 256 + ct;
#pragma unroll
                    for (int bj = 0; bj < 2; ++bj) { f32x4 v0 = acc[ai][bj][m][0], v1 = acc[ai][bj][m][1];
#pragma unroll
                        for (int i = 0; i < 4; ++i) { v0[i] = silu_(v0[i]); v1[i] = silu_(v1[i]); }
                        *(u32x4*)(rp + bj * 128) = pack8(v0, v1); } }
        } else if (pn >= 8 && pn < 12) {
            bf16_t* buf = qkv + (size_t)(pn < 10 ? 3 : 4) * SB; const float sc = pn < 10 ? C2 : 1.f;
#pragma unroll
            for (int ai = 0; ai < 2; ++ai)
#pragma unroll
                for (int m = 0; m < 4; ++m) { const int row = row0 + ai * 128 + m * 16; const int b = row >> 13, s = row & (SEQ - 1);
#pragma unroll
                    for (int bj = 0; bj < 2; ++bj) { const int colp = (pn & 1) * 256 + bj * 128 + ct; const int strm = colp >> 6, a = (colp & 63) >> 3;
                        const f32x4 c4 = *(const f32x4*)(cs + s * 32 + 4 * a), s4 = *(const f32x4*)(sn + s * 32 + 4 * a);
                        const f32x4 v0 = acc[ai][bj][m][0], v1 = acc[ai][bj][m][1];
                        const f32x4 lo = (v0 * c4 - v1 * s4) * sc, hi = (v1 * c4 + v0 * s4) * sc;
                        bf16_t* dst = buf + ((size_t)(b * 8 + strm) * SEQ + s) * 64 + 4 * a;
                        u32x2 w0, w1; w0.x = pk_bf16(lo[0], lo[1]); w0.y = pk_bf16(lo[2], lo[3]); w1.x = pk_bf16(hi[0], hi[1]); w1.y = pk_bf16(hi[2], hi[3]);
                        *(u32x2*)dst = w0; *(u32x2*)(dst + 32) = w1; } }
        } else {
            bf16_t* buf = qkv + (size_t)(pn >= 12 ? 5 : (pn >> 1)) * SB; const float sc = pn < 2 ? C2 : 1.f;
#pragma unroll
            for (int ai = 0; ai < 2; ++ai)
#pragma unroll
                for (int m = 0; m < 4; ++m) { const int row = row0 + ai * 128 + m * 16; const int b = row >> 13, s = row & (SEQ - 1);
#pragma unroll
                    for (int bj = 0; bj < 2; ++bj) { const int colp = (pn & 1) * 256 + bj * 128 + ct; const int strm = colp >> 6, d = colp & 63;
                        const f32x4 v0 = acc[ai][bj][m][0] * sc, v1 = acc[ai][bj][m][1] * sc;
                        *(u32x4*)(buf + ((size_t)(b * 8 + strm) * SEQ + s) * 64 + d) = pack8(v0, v1);
                        if (pn == 2 || pn == 3) {
                            float ps = (v0[0] * v0[0] + v0[1] * v0[1]) + (v0[2] * v0[2] + v0[3] * v0[3]) + (v1[0] * v1[0] + v1[1] * v1[1]) + (v1[2] * v1[2] + v1[3] * v1[3]);
                            ps += __shfl_xor(ps, 16); ps += __shfl_xor(ps, 32);
                            if (fq == 0) atomicAdd(kn2 + (size_t)(b * 8 + strm) * SEQ + s, ps); } } }
        }
    }
};

struct Sched3a {
    pg8::StaticOrder so;
    __device__ bool next(int i, Unit& u) const { if (!so.next(i >> 1, u)) return false; const int br = i & 1; u.pm += 256 * br; u.pn += 4 * br; return true; }
    __device__ __forceinline__ void a_ready(const Unit&) const {}
    __device__ __forceinline__ void done(const Unit&) const {}
};
struct Epi3a {
    static constexpr bool PERM = true, AFTER_DRAIN = false;
    const bf16_t* g; bf16_t* T; bf16_t* merged;
    __device__ __forceinline__ void operator()(const f32x4 (&acc)[2][2][4][2], const Unit& u, int wr, int wc, int fr, int fq) const {
        const int br = u.pm >= 256 ? 1 : 0; const int pm = u.pm - 256 * br, pn = u.pn - 4 * br;
        const int row0 = pm * 256 + wr * 64 + fr; const int col0 = pn * 256 + wc * 32 + 8 * fq;
#pragma unroll
        for (int ai = 0; ai < 2; ++ai)
#pragma unroll
            for (int m = 0; m < 4; ++m) { const int row = row0 + ai * 128 + m * 16;
#pragma unroll
                for (int bj = 0; bj < 2; ++bj) { const int col = col0 + bj * 128;
                    const u32x4 gw = *(const u32x4*)(g + (size_t)row * 2048 + br * 1024 + col);
                    const f32x4 g0 = {bf_lo(gw.x), bf_hi(gw.x), bf_lo(gw.y), bf_hi(gw.y)}, g1 = {bf_lo(gw.z), bf_hi(gw.z), bf_lo(gw.w), bf_hi(gw.w)};
                    bf16_t* tp = T + (size_t)row * 1024 + col;
                    if (br == 0) { *(u32x4*)tp = pack8(g0 * acc[ai][bj][m][0], g1 * acc[ai][bj][m][1]); }
                    else { const u32x4 tw = *(const u32x4*)tp;
                        const f32x4 t0 = {bf_lo(tw.x), bf_hi(tw.x), bf_lo(tw.y), bf_hi(tw.y)}, t1 = {bf_lo(tw.z), bf_hi(tw.z), bf_lo(tw.w), bf_hi(tw.w)};
                        *(u32x4*)(merged + (size_t)row * 1024 + col) = pack8(t0 + g0 * acc[ai][bj][m][0], t1 + g1 * acc[ai][bj][m][1]); } } }
    }
};
struct Epi3b {
    static constexpr bool PERM = true, AFTER_DRAIN = false;
    bf16_t* y; float* ssq;
    __device__ __forceinline__ void operator()(const f32x4 (&acc)[2][2][4][2], const Unit& u, int wr, int wc, int fr, int fq) const {
        const int row0 = u.pm * 256 + wr * 64 + fr; const int col0 = u.pn * 256 + wc * 32 + 8 * fq;
#pragma unroll
        for (int ai = 0; ai < 2; ++ai)
#pragma unroll
            for (int m = 0; m < 4; ++m) { const int row = row0 + ai * 128 + m * 16; float s = 0.f;
#pragma unroll
                for (int bj = 0; bj < 2; ++bj) { const f32x4 v0 = acc[ai][bj][m][0], v1 = acc[ai][bj][m][1];
                    *(u32x4*)(y + (size_t)row * 1024 + col0 + bj * 128) = pack8(v0, v1);
                    s += (v0[0] * v0[0] + v0[1] * v0[1]) + (v0[2] * v0[2] + v0[3] * v0[3]) + (v1[0] * v1[0] + v1[1] * v1[1]) + (v1[2] * v1[2] + v1[3] * v1[3]); }
                s += __shfl_xor(s, 16); s += __shfl_xor(s, 32);
                if (fq == 0) atomicAdd(ssq + row, s); }
    }
};

constexpr int A_KB = 8448  , A_VBASE = 2 * A_KB, A_VB = 16384, A_WSF = A_VBASE + 2 * A_VB, A_MISC = A_WSF + 8 * 128, A_STAGE = 61440  ;
typedef short v4i16_t __attribute__((ext_vector_type(4)));
__device__ __forceinline__ s16x4 tr_read(LAS unsigned char* p) { return __builtin_bit_cast(s16x4, __builtin_amdgcn_ds_read_tr16_b64_v4i16((LAS v4i16_t*)p)); }
__device__ __forceinline__ float half_max(float m) { auto rr = __builtin_amdgcn_permlane32_swap(__float_as_uint(m), __float_as_uint(m), false, false); return fmaxf(__uint_as_float(rr[0]), __uint_as_float(rr[1])); }
__device__ __forceinline__ float half_sum(float m) { auto rr = __builtin_amdgcn_permlane32_swap(__float_as_uint(m), __float_as_uint(m), false, false); return __uint_as_float(rr[0]) + __uint_as_float(rr[1]); }

template <bool BIAS>
__device__ __forceinline__ void qk_tile(LAS unsigned char* Kb, const bf16x8 (&qr)[4], unsigned ka_off, int hi, f32x16& s0, f32x16& s1) {
    if (BIAS) {
#pragma unroll
        for (int j = 0; j < 4; ++j) { const f32x4 b0 = *(LAS f32x4*)(Kb + 8192 + (8 * j + 4 * hi) * 4), b1 = *(LAS f32x4*)(Kb + 8192 + 128 + (8 * j + 4 * hi) * 4);
#pragma unroll
            for (int i = 0; i < 4; ++i) { s0[4 * j + i] = b0[i]; s1[4 * j + i] = b1[i]; } }
    } else { s0 = f32x16{}; s1 = f32x16{}; }
#pragma unroll
    for (int s = 0; s < 4; ++s) {
        const bf16x8 k0 = *(LAS bf16x8*)(Kb + ka_off + s * 2048), k1 = *(LAS bf16x8*)(Kb + ka_off + s * 2048 + 512);
        s0 = __builtin_amdgcn_mfma_f32_32x32x16_bf16(k0, qr[s], s0, 0, 0, 0);
        s1 = __builtin_amdgcn_mfma_f32_32x32x16_bf16(k1, qr[s], s1, 0, 0, 0);
    }
}
__device__ __forceinline__ void mask_tile(f32x16& s0, f32x16& s1, int t, int qg, int hi) {
    const int kb = 64 * t + 4 * hi;
#pragma unroll
    for (int r = 0; r < 16; ++r) { const int kv = kb + (r & 3) + 8 * (r >> 2); if (kv > qg) s0[r] = -INFINITY; if (kv + 32 > qg) s1[r] = -INFINITY; }
}
__device__ __forceinline__ float rowmax32(const f32x16& s0, const f32x16& s1) {
    float a = fmaxf(fmaxf(s0[0], s0[1]), s1[0]), b = fmaxf(fmaxf(s0[2], s0[3]), s1[1]); a = fmaxf(fmaxf(a, s1[2]), s1[3]);
#pragma unroll
    for (int r = 4; r < 16; r += 4) { a = fmaxf(fmaxf(a, s0[r]), s0[r + 1]); b = fmaxf(fmaxf(b, s0[r + 2]), s0[r + 3]); a = fmaxf(fmaxf(a, s1[r]), s1[r + 1]); b = fmaxf(fmaxf(b, s1[r + 2]), s1[r + 3]); }
    return half_max(fmaxf(a, b));
}
template <int NV>
__device__ __forceinline__ void softmax_pv(LAS unsigned char* Vb, LAS float* wsf, f32x16& p0, f32x16& p1, float mx, float& m_run, float& l_run, f32x16 (&o)[NV][2], unsigned vb0, unsigned vb1, int r32, int hi) {
    const float m_new = fmaxf(m_run, mx);
    const float alpha = __builtin_amdgcn_exp2f(m_run - m_new);
    m_run = m_new;
    float ls = 0.f;
#pragma unroll
    for (int r = 0; r < 16; ++r) { p0[r] = __builtin_amdgcn_exp2f(p0[r] - m_new); p1[r] = __builtin_amdgcn_exp2f(p1[r] - m_new); ls += p0[r] + p1[r]; }
    l_run = l_run * alpha + ls;
    if (__any(alpha != 1.0f)) {
        if (hi == 0) wsf[r32] = alpha;
#pragma unroll
        for (int j = 0; j < 4; ++j) { const f32x4 a = *(LAS f32x4*)(wsf + 8 * j + 4 * hi);
#pragma unroll
            for (int nv = 0; nv < NV; ++nv)
#pragma unroll
                for (int d0 = 0; d0 < 2; ++d0)
#pragma unroll
                    for (int i = 0; i < 4; ++i) o[nv][d0][4 * j + i] *= a[i]; }
    }
    bf16x8 pa[4];
    { u32x4 w;
      w.x = pk_bf16(p0[0], p0[1]); w.y = pk_bf16(p0[2], p0[3]); w.z = pk_bf16(p0[4], p0[5]); w.w = pk_bf16(p0[6], p0[7]); pa[0] = __builtin_bit_cast(bf16x8, w);
      w.x = pk_bf16(p0[8], p0[9]); w.y = pk_bf16(p0[10], p0[11]); w.z = pk_bf16(p0[12], p0[13]); w.w = pk_bf16(p0[14], p0[15]); pa[1] = __builtin_bit_cast(bf16x8, w);
      w.x = pk_bf16(p1[0], p1[1]); w.y = pk_bf16(p1[2], p1[3]); w.z = pk_bf16(p1[4], p1[5]); w.w = pk_bf16(p1[6], p1[7]); pa[2] = __builtin_bit_cast(bf16x8, w);
      w.x = pk_bf16(p1[8], p1[9]); w.y = pk_bf16(p1[10], p1[11]); w.z = pk_bf16(p1[12], p1[13]); w.w = pk_bf16(p1[14], p1[15]); pa[3] = __builtin_bit_cast(bf16x8, w); }
#pragma unroll
    for (int nv = 0; nv < NV; ++nv)
#pragma unroll
        for (int d0 = 0; d0 < 2; ++d0) {
            LAS unsigned char* vp = Vb + nv * 8192 + (d0 ? vb1 : vb0);
#pragma unroll
            for (int s = 0; s < 4; ++s) {
                const s16x4 lo = tr_read(vp + s * 2048), hh = tr_read(vp + s * 2048 + 1024);
                const bf16x8 vf = {lo[0], lo[1], lo[2], lo[3], hh[0], hh[1], hh[2], hh[3]};
                o[nv][d0] = __builtin_amdgcn_mfma_f32_32x32x16_bf16(pa[s], vf, o[nv][d0], 0, 0, 0);
            }
        }
}

__device__ __forceinline__ void qk_load(LAS unsigned char* Kb, unsigned ka_off, bf16x8 (&kf)[8]) {
#pragma unroll
    for (int s = 0; s < 4; ++s) { kf[2 * s] = *(LAS bf16x8*)(Kb + ka_off + s * 2048); kf[2 * s + 1] = *(LAS bf16x8*)(Kb + ka_off + s * 2048 + 512); }
}
template <bool BIAS>
__device__ __forceinline__ void qk_mma(LAS unsigned char* Kb, const bf16x8 (&kf)[8], const bf16x8 (&qr)[4], int hi, f32x16& s0, f32x16& s1, const f32x16& cinit) {
    if (BIAS) {
#pragma unroll
        for (int j = 0; j < 4; ++j) { const f32x4 b0 = *(LAS f32x4*)(Kb + 8192 + (8 * j + 4 * hi) * 4), b1 = *(LAS f32x4*)(Kb + 8192 + 128 + (8 * j + 4 * hi) * 4);
#pragma unroll
            for (int i = 0; i < 4; ++i) { s0[4 * j + i] = b0[i]; s1[4 * j + i] = b1[i]; } }
    }
    if (BIAS) {
#pragma unroll
        for (int s = 0; s < 4; ++s) {
            s0 = __builtin_amdgcn_mfma_f32_32x32x16_bf16(kf[2 * s], qr[s], s0, 0, 0, 0);
            s1 = __builtin_amdgcn_mfma_f32_32x32x16_bf16(kf[2 * s + 1], qr[s], s1, 0, 0, 0);
        }
    } else {
        s0 = __builtin_amdgcn_mfma_f32_32x32x16_bf16(kf[0], qr[0], cinit, 0, 0, 0);
        s1 = __builtin_amdgcn_mfma_f32_32x32x16_bf16(kf[1], qr[0], cinit, 0, 0, 0);
#pragma unroll
        for (int s = 1; s < 4; ++s) {
            s0 = __builtin_amdgcn_mfma_f32_32x32x16_bf16(kf[2 * s], qr[s], s0, 0, 0, 0);
            s1 = __builtin_amdgcn_mfma_f32_32x32x16_bf16(kf[2 * s + 1], qr[s], s1, 0, 0, 0);
        }
    }
}
__device__ __forceinline__ void v_load(LAS unsigned char* vp, s16x4 (&v)[8]) {
#pragma unroll
    for (int s = 0; s < 4; ++s) { v[2 * s] = tr_read(vp + s * 2048); v[2 * s + 1] = tr_read(vp + s * 2048 + 1024); }
}
__device__ __forceinline__ void pv_mma(const bf16x8 (&pa)[4], const s16x4 (&v)[8], f32x16& oo) {
#pragma unroll
    for (int s = 0; s < 4; ++s) { const bf16x8 vf = {v[2 * s][0], v[2 * s][1], v[2 * s][2], v[2 * s][3], v[2 * s + 1][0], v[2 * s + 1][1], v[2 * s + 1][2], v[2 * s + 1][3]};
        oo = __builtin_amdgcn_mfma_f32_32x32x16_bf16(pa[s], vf, oo, 0, 0, 0); }
}
template <int NV>
__device__ __forceinline__ void softmax_pv3(LAS unsigned char* Vb, LAS float* wsf, f32x16& p0, f32x16& p1, float mx, float& m_run, float& l_run, f32x16 (&o)[NV][2], s16x4 (&va)[8], s16x4 (&vb)[8], unsigned vb0, unsigned vb1, int r32, int hi) {
    const float m_new = fmaxf(m_run, mx);
    const float alpha = __builtin_amdgcn_exp2f(m_run - m_new);
    m_run = m_new;
    if (__any(alpha != 1.0f)) {
        if (hi == 0) wsf[r32] = alpha;
#pragma unroll
        for (int j = 0; j < 4; ++j) { const f32x4 a = *(LAS f32x4*)(wsf + 8 * j + 4 * hi);
#pragma unroll
            for (int nv = 0; nv < NV; ++nv)
#pragma unroll
                for (int d0 = 0; d0 < 2; ++d0)
#pragma unroll
                    for (int i = 0; i < 4; ++i) o[nv][d0][4 * j + i] *= a[i]; }
    }
    float ls = 0.f;
#pragma unroll
    for (int r = 0; r < 16; ++r) { p0[r] = __builtin_amdgcn_exp2f(p0[r] - m_new); p1[r] = __builtin_amdgcn_exp2f(p1[r] - m_new); ls += p0[r] + p1[r]; }
    l_run = l_run * alpha + ls;
    bf16x8 pa[4];
    { u32x4 w;
      w.x = pk_bf16(p0[0], p0[1]); w.y = pk_bf16(p0[2], p0[3]); w.z = pk_bf16(p0[4], p0[5]); w.w = pk_bf16(p0[6], p0[7]); pa[0] = __builtin_bit_cast(bf16x8, w);
      w.x = pk_bf16(p0[8], p0[9]); w.y = pk_bf16(p0[10], p0[11]); w.z = pk_bf16(p0[12], p0[13]); w.w = pk_bf16(p0[14], p0[15]); pa[1] = __builtin_bit_cast(bf16x8, w);
      w.x = pk_bf16(p1[0], p1[1]); w.y = pk_bf16(p1[2], p1[3]); w.z = pk_bf16(p1[4], p1[5]); w.w = pk_bf16(p1[6], p1[7]); pa[2] = __builtin_bit_cast(bf16x8, w);
      w.x = pk_bf16(p1[8], p1[9]); w.y = pk_bf16(p1[10], p1[11]); w.z = pk_bf16(p1[12], p1[13]); w.w = pk_bf16(p1[14], p1[15]); pa[3] = __builtin_bit_cast(bf16x8, w); }
    pv_mma(pa, va, o[0][0]);
    if (NV == 2) { v_load(Vb + 8192 + vb0, va); __builtin_amdgcn_sched_barrier(0); }
    pv_mma(pa, vb, o[0][1]);
    if (NV == 2) {
        v_load(Vb + 8192 + vb1, vb); __builtin_amdgcn_sched_barrier(0);
        pv_mma(pa, va, o[NV - 1][0]);
        pv_mma(pa, vb, o[NV - 1][1]);
    }
}

template <int NV>
__device__ __forceinline__ void v_load_ks(LAS unsigned char* Vb, unsigned vb0, unsigned vb1, int s, s16x4 (&v)[4 * NV]) {
#pragma unroll
    for (int g = 0; g < 2 * NV; ++g) { LAS unsigned char* vp = Vb + (g >> 1) * 8192 + ((g & 1) ? vb1 : vb0) + s * 2048; v[2 * g] = tr_read(vp); v[2 * g + 1] = tr_read(vp + 1024); }
}
template <int NV>
__device__ __forceinline__ void softmax_pv4(LAS unsigned char* Vb, LAS float* wsf, f32x16& p0, f32x16& p1, float mx, float& m_run, float& l_run, f32x16 (&o)[NV][2], s16x4 (&va)[4 * NV], unsigned vb0, unsigned vb1, int r32, int hi, f32x16& negm, bool& started, LAS unsigned char* Kb, unsigned ka_off, bf16x8 (&kf)[8], const bool do_next) {
    constexpr bool LAZY = (NV == 2);
    float m_new, alpha;
    if constexpr (LAZY) {
        const bool first = !started;
        if (first || __any(mx > 8.0f)) {
            const float dl = first ? mx : fmaxf(mx, 0.f);
            m_run += dl;
#pragma unroll
            for (int r = 0; r < 16; ++r) { p0[r] -= dl; p1[r] -= dl; }
#pragma unroll
            for (int r = 0; r < 16; ++r) negm[r] = -m_run;
            alpha = first ? 1.0f : __builtin_amdgcn_exp2f(-dl);
            l_run *= alpha;
        } else alpha = 1.0f;
        started = true; m_new = 0.f;
    } else {
        m_new = fmaxf(m_run, mx);
        alpha = __builtin_amdgcn_exp2f(m_run - m_new);
        m_run = m_new;
    }
    if (__any(alpha != 1.0f)) {
        if (hi == 0) wsf[r32] = alpha;
#pragma unroll
        for (int j = 0; j < 4; ++j) { const f32x4 a = *(LAS f32x4*)(wsf + 8 * j + 4 * hi);
#pragma unroll
            for (int nv = 0; nv < NV; ++nv)
#pragma unroll
                for (int d0 = 0; d0 < 2; ++d0)
#pragma unroll
                    for (int i = 0; i < 4; ++i) o[nv][d0][4 * j + i] *= a[i]; }
    }
    typedef float f32x2v __attribute__((ext_vector_type(2)));
    f32x2v ls2_ = {0.f, 0.f}; const f32x2v m2_ = {m_new, m_new};
    s16x4 vbb[4 * NV];
    u32x4 w0, w1, w2, w3;
#define PV4_E2(P, B, W, C) do { const f32x2v t_ = (f32x2v){P[B], P[B + 1]} - m2_; const f32x2v e_ = {__builtin_amdgcn_exp2f(t_.x), __builtin_amdgcn_exp2f(t_.y)}; ls2_ += e_; W[C] = pk_bf16(e_.x, e_.y); } while (0)
#define PV4_MF(W, V, G) do { const bf16x8 vf_ = {V[2 * (G)][0], V[2 * (G)][1], V[2 * (G)][2], V[2 * (G)][3], V[2 * (G) + 1][0], V[2 * (G) + 1][1], V[2 * (G) + 1][2], V[2 * (G) + 1][3]}; \
        o[(G) >> 1][(G) & 1] = __builtin_amdgcn_mfma_f32_32x32x16_bf16(__builtin_bit_cast(bf16x8, W), vf_, o[(G) >> 1][(G) & 1], 0, 0, 0); } while (0)
#define SB() __builtin_amdgcn_sched_barrier(0)
#define PV4_TR(S, G, DST) do { LAS unsigned char* vp_ = Vb + ((G) >> 1) * 8192 + (((G) & 1) ? vb1 : vb0) + (S) * 2048; DST[2 * (G)] = tr_read(vp_); DST[2 * (G) + 1] = tr_read(vp_ + 1024); } while (0)
#define PV4_KL(G) do { if (do_next) { kf[2 * (G)] = *(LAS bf16x8*)(Kb + ka_off + (G) * 2048); kf[2 * (G) + 1] = *(LAS bf16x8*)(Kb + ka_off + (G) * 2048 + 512); } } while (0)
    PV4_E2(p0, 0, w0, 0); PV4_E2(p0, 2, w0, 1); PV4_E2(p0, 4, w0, 2); PV4_E2(p0, 6, w0, 3); SB();
    if (NV == 2) {
        PV4_MF(w0, va, 0); PV4_TR(1, 0, vbb); PV4_E2(p0, 8, w1, 0); SB(); PV4_MF(w0, va, 1); PV4_TR(1, 1, vbb); PV4_E2(p0, 10, w1, 1); SB();
        PV4_MF(w0, va, 2); PV4_TR(1, 2, vbb); PV4_E2(p0, 12, w1, 2); SB(); PV4_MF(w0, va, 3); PV4_TR(1, 3, vbb); PV4_E2(p0, 14, w1, 3); SB();
        PV4_MF(w1, vbb, 0); PV4_TR(2, 0, va); PV4_E2(p1, 0, w2, 0); SB(); PV4_MF(w1, vbb, 1); PV4_TR(2, 1, va); PV4_E2(p1, 2, w2, 1); SB();
        PV4_MF(w1, vbb, 2); PV4_TR(2, 2, va); PV4_E2(p1, 4, w2, 2); SB(); PV4_MF(w1, vbb, 3); PV4_TR(2, 3, va); PV4_E2(p1, 6, w2, 3); SB();
        PV4_MF(w2, va, 0); PV4_TR(3, 0, vbb); PV4_E2(p1, 8, w3, 0); SB(); PV4_MF(w2, va, 1); PV4_TR(3, 1, vbb); PV4_E2(p1, 10, w3, 1); SB();
        PV4_MF(w2, va, 2); PV4_TR(3, 2, vbb); PV4_E2(p1, 12, w3, 2); SB(); PV4_MF(w2, va, 3); PV4_TR(3, 3, vbb); PV4_E2(p1, 14, w3, 3); SB();
        PV4_MF(w3, vbb, 0); PV4_KL(0); SB(); PV4_MF(w3, vbb, 1); PV4_KL(1); SB(); PV4_MF(w3, vbb, 2); PV4_KL(2); SB(); PV4_MF(w3, vbb, 3); PV4_KL(3); SB();
    } else {
        PV4_MF(w0, va, 0); PV4_TR(1, 0, vbb); PV4_E2(p0, 8, w1, 0); PV4_E2(p0, 10, w1, 1); SB(); PV4_MF(w0, va, 1); PV4_TR(1, 1, vbb); PV4_E2(p0, 12, w1, 2); PV4_E2(p0, 14, w1, 3); SB();
        PV4_MF(w1, vbb, 0); PV4_TR(2, 0, va); PV4_E2(p1, 0, w2, 0); PV4_E2(p1, 2, w2, 1); SB(); PV4_MF(w1, vbb, 1); PV4_TR(2, 1, va); PV4_E2(p1, 4, w2, 2); PV4_E2(p1, 6, w2, 3); SB();
        PV4_MF(w2, va, 0); PV4_TR(3, 0, vbb); PV4_E2(p1, 8, w3, 0); PV4_E2(p1, 10, w3, 1); SB(); PV4_MF(w2, va, 1); PV4_TR(3, 1, vbb); PV4_E2(p1, 12, w3, 2); PV4_E2(p1, 14, w3, 3); SB();
        PV4_MF(w3, vbb, 0); PV4_KL(0); PV4_KL(1); SB(); PV4_MF(w3, vbb, 1); PV4_KL(2); PV4_KL(3); SB();
    }
#undef PV4_TR
#undef PV4_KL
#undef PV4_E2
#undef PV4_MF
#undef SB
    l_run = (LAZY ? l_run : l_run * alpha) + (ls2_.x + ls2_.y);
}

template <int NV, bool BIAS>
__device__ __forceinline__ void attn_pass(LAS unsigned char* L, const bf16_t* __restrict__ Qp, const bf16_t* __restrict__ Kp, const bf16_t* __restrict__ Vp0, const bf16_t* __restrict__ Vp1,
                                          const float* __restrict__ cbp, int qb, f32x16 (&o)[NV][2], const int tid, const float* __restrict__ kn2p, const float gk) {
    const int lane = tid & 63, r32 = lane & 31, hi = lane >> 5;
    const int wid = __builtin_amdgcn_readfirstlane(tid >> 6);
    const int q0w = qb * 256 + wid * 32, qg = q0w + r32;
    const int NT = 4 * qb + 4, T0 = NT - 1, tmax = 4 * qb + (wid >> 1);
    bf16x8 qr[4];
#pragma unroll
    for (int s = 0; s < 4; ++s) qr[s] = *(const bf16x8*)(Qp + (size_t)(q0w + r32) * 64 + 16 * s + 8 * hi);
    int NS = NT;
    if (BIAS) {
        LAS unsigned* mw = (LAS unsigned*)(L + A_MISC);
        float q2 = 0.f;
#pragma unroll
        for (int s = 0; s < 4; ++s)
#pragma unroll
            for (int j = 0; j < 8; ++j) { const float v = __uint_as_float(((unsigned)(unsigned short)qr[s][j]) << 16); q2 += v * v; }
        const float qn = sqrtf(half_sum(q2)) * 1.02f;
        float val = cbp[qg] - qn * (gk + sqrtf(kn2p[qg]) * 1.02f) - 170.0f;
        val = fminf(val, __shfl_xor(val, 1)); val = fminf(val, __shfl_xor(val, 2)); val = fminf(val, __shfl_xor(val, 4)); val = fminf(val, __shfl_xor(val, 8)); val = fminf(val, __shfl_xor(val, 16));
        if (tid == 0) mw[2] = 0u;
        if (lane == 0) ((LAS float*)mw)[4 + wid] = val;
        __syncthreads();
        float thr = ((LAS float*)mw)[4];
#pragma unroll
        for (int w = 1; w < 8; ++w) thr = fminf(thr, ((LAS float*)mw)[4 + w]);
        if (gk >= 0.f && tid < NT && cbp[64 * tid + 63] < thr) __hip_atomic_fetch_max(mw + 2, (unsigned)(tid + 1), __ATOMIC_RELAXED, __HIP_MEMORY_SCOPE_WORKGROUP);
        __syncthreads();
        int t_stop = (int)mw[2];
        if ((NT - t_stop) & 1) t_stop -= 1;
        NS = NT - t_stop;
    }
    const int kvr = tid >> 3, chv = tid & 7;
    const bf16_t* kg = Kp + (size_t)lane * 64 + wid * 8;
    const int vxo = kvr * 64 + ((chv ^ (((kvr >> 1) & 1) << 2)) << 3);
    const bf16_t* vgx0 = Vp0 + vxo;
    const bf16_t* vgx1 = Vp1 + vxo;
    const unsigned ka_off = hi * 1024 + r32 * 16;
    const int g1 = (lane >> 4) & 1, qq = (lane & 15) >> 2, pp = lane & 3, xq = (qq >> 1) & 1;
    const unsigned vrow = (4 * hi + qq) * 128 + 32 * g1 + 8 * pp;
    const unsigned vb0 = vrow + (xq ? 64 : 0), vb1 = vrow + (xq ? 0 : 64);
    LAS float* wsf = (LAS float*)(L + A_WSF + wid * 128);
    f32x4 bst = {0.f, 0.f, 0.f, 0.f};
    float m_run = (NV == 2) ? 0.f : -1e30f, l_run = 0.f; f32x16 negm = f32x16{}; bool started = false;
#pragma unroll
    for (int nv = 0; nv < NV; ++nv) { o[nv][0] = f32x16{}; o[nv][1] = f32x16{}; }
#define ATT_LOADK(tt) do { __builtin_amdgcn_global_load_lds((const unsigned*)(kg + (size_t)(tt) * 4096), (LAS unsigned*)(L + kdst_ * A_KB + wid * 1024), 16, 0, 0); \
        if (BIAS && tid < 16) bst = *(const f32x4*)(cbp + (tt) * 64 + tid * 4); } while (0)
#define ATT_LOADV(tt) do { __builtin_amdgcn_global_load_lds((const unsigned*)(vgx0 + (size_t)(tt) * 4096), (LAS unsigned*)(L + A_VBASE + vdst_ * A_VB + wid * 1024), 16, 0, 0); \
        if (NV == 2) __builtin_amdgcn_global_load_lds((const unsigned*)(vgx1 + (size_t)(tt) * 4096), (LAS unsigned*)(L + A_VBASE + vdst_ * A_VB + 8192 + wid * 1024), 16, 0, 0); } while (0)
#define ATT_STOREK(b) do { if (BIAS && tid < 16) *(LAS f32x4*)(L + (b) * A_KB + 8192 + tid * 16) = bst; } while (0)
#define ATT_STOREV(b) do { } while (0)
    int kdst_ = 0, vdst_ = 0;
    kdst_ = 0; vdst_ = 0; ATT_LOADK(T0); ATT_LOADV(T0); ATT_STOREK(0);
    kdst_ = 1; ATT_LOADK(T0 - 1); ATT_STOREK(1);
    __syncthreads();
    f32x16 s0, s1;
    if (T0 <= tmax) { qk_tile<BIAS>(L, qr, ka_off, hi, s0, s1); mask_tile(s0, s1, T0, qg, hi); }
    __syncthreads();
    bf16x8 kf[8]; s16x4 va[4 * NV];
#define ATT_STEP(i) do { \
        const int t_ = T0 - (i); const int kb_ = ((i) + 1) & 1, vbuf_ = (i) & 1; \
        { const int tk_ = t_ - 2 > 0 ? t_ - 2 : 0, tv_ = t_ - 1 > 0 ? t_ - 1 : 0; kdst_ = vbuf_; vdst_ = kb_; ATT_LOADK(tk_); ATT_LOADV(tv_); } \
        LAS unsigned char* Kb_ = L + kb_ * A_KB; LAS unsigned char* Vb_ = L + A_VBASE + vbuf_ * A_VB; \
        const bool do_next_ = (t_ >= 1) && (t_ - 1 <= tmax); \
        bool do_cur_ = (t_ <= tmax); float mxc_ = 0.f; \
        if (do_cur_) { v_load_ks<NV>(Vb_, vb0, vb1, 0, va); __builtin_amdgcn_sched_barrier(0); \
                       mxc_ = rowmax32(s0, s1); if (BIAS) do_cur_ = __any(mxc_ >= m_run - 160.0f) != 0; } \
        if (do_next_ && NV == 1 && !do_cur_) { qk_load(Kb_, ka_off, kf); __builtin_amdgcn_sched_barrier(0); } \
        if (do_cur_) softmax_pv4<NV>(Vb_, wsf, s0, s1, mxc_, m_run, l_run, o, va, vb0, vb1, r32, hi, negm, started, Kb_, ka_off, kf, NV == 1 && do_next_); \
        if (do_next_) { if (NV == 2) qk_load(Kb_, ka_off, kf); qk_mma<BIAS>(Kb_, kf, qr, hi, s0, s1, negm); if (64 * (t_ - 1) + 63 > q0w) mask_tile(s0, s1, t_ - 1, qg, hi); } \
        ATT_STOREK(vbuf_); ATT_STOREV(kb_); \
        __syncthreads(); } while (0)
    for (int i = 0; i < NS; i += 2) { ATT_STEP(i); ATT_STEP(i + 1); }
#undef ATT_STEP
#undef ATT_LOADK
#undef ATT_LOADV
#undef ATT_STOREK
#undef ATT_STOREV
    const float inv = 1.0f / half_sum(l_run);
    if (hi == 0) wsf[r32] = inv;
#pragma unroll
    for (int j = 0; j < 4; ++j) { const f32x4 a = *(LAS f32x4*)(wsf + 8 * j + 4 * hi);
#pragma unroll
        for (int nv = 0; nv < NV; ++nv)
#pragma unroll
            for (int d0 = 0; d0 < 2; ++d0)
#pragma unroll
                for (int i = 0; i < 4; ++i) o[nv][d0][4 * j + i] *= a[i]; }
}

struct AttnArgs { const bf16_t* qkv; const float* cb; const bf16_t* z; bf16_t* y; float* park; const float* kn2; unsigned* counter; const float* gsub; float lam; };

__device__ __forceinline__ int lane_now() { int l; asm volatile("v_mbcnt_lo_u32_b32 %0, -1, 0\n\tv_mbcnt_hi_u32_b32 %0, -1, %0" : "=v"(l)); return l; }
__device__ __forceinline__ float xlane(float v, int src_lane) { return __int_as_float(__builtin_amdgcn_ds_bpermute(src_lane << 2, __float_as_int(v))); }
__device__ __forceinline__ void attn_phase(LAS unsigned char* L, const AttnArgs& A, const int wv  ) {
    LAS unsigned* misc = (LAS unsigned*)(L + A_MISC);
    const int xcd = blockIdx.x & 7;
    {
        const int w0 = wv, l0 = lane_now(); const float* kp = A.kn2 + (size_t)(xcd * 8 + w0) * SEQ; float mx = 0.f;
        for (int i = l0; i < SEQ; i += 64) mx = fmaxf(mx, kp[i]);
#pragma unroll
        for (int o = 1; o < 64; o <<= 1) mx = fmaxf(mx, __shfl_xor(mx, o));
        if (l0 == 0) ((LAS float*)misc)[16 + w0] = sqrtf(mx) * 1.02f;
    }
    for (int kq = 0; kq < 8; ++kq) {
    const int qx = (xcd + kq) & 7;
    for (;;) {
        __syncthreads();
        if (wv == 0 && lane_now() == 0) misc[0] = atomicAdd(A.counter + 32 * qx, 1u);
        __syncthreads();
        const unsigned idx = misc[0];
        if (idx >= 384u) break;
        const int slot = idx >> 5; const int qb = 31 - (int)(idx & 31u);
        const unsigned code = slot < 4 ? 2048u + (unsigned)((qx * 4 + slot) * 32 + qb) : (unsigned)((qx * 8 + (slot - 4)) * 32 + qb);
        const int wid = wv;
        const int q0w = qb * 256 + wid * 32;
#ifndef ATT_TEST
#define ATT_TEST 3
#endif
        if ((ATT_TEST & 1) && code < 2048u) {
            const int tid = wv * 64 + lane_now();
            const int bh = code >> 5, b = bh >> 3, h = bh & 7;
            const size_t so = (size_t)bh * SEQ * 64;
            f32x16 o[1][2];
            const float gkv = (b == xcd) ? ((LAS float*)misc)[16 + h] : -1.0f;
            attn_pass<1, true>(L, A.qkv + so, A.qkv + SB + so, A.qkv + 2 * SB + so, nullptr, A.cb + (size_t)bh * SEQ, qb, o, tid, A.kn2 + (size_t)bh * SEQ, gkv);
            {
                const int lane1 = lane_now(); const int r32e = lane1 & 31, hie = lane1 >> 5;
                LAS float* st = (LAS float*)(L + A_STAGE + wid * 8704);
#pragma unroll
                for (int d0 = 0; d0 < 2; ++d0)
#pragma unroll
                    for (int r = 0; r < 16; ++r) st[((r & 3) + 8 * (r >> 2) + 4 * hie) * 68 + 32 * d0 + r32e] = o[0][d0][r];
                const int rsub = lane1 >> 3, c8 = (lane1 & 7) * 8;
                size_t gbase = (size_t)(b * SEQ + q0w + rsub) * 512 + h * 64 + c8; asm volatile("" : "+v"(gbase));
#pragma unroll
                for (int it = 0; it < 4; ++it) {
                    const f32x4 v0 = *(LAS f32x4*)(st + (it * 8 + rsub) * 68 + c8), v1 = *(LAS f32x4*)(st + (it * 8 + rsub) * 68 + c8 + 4);
                    const u32x4 zw = *(const u32x4*)(A.z + gbase + (size_t)it * 8 * 512);
                    const f32x4 z0 = {bf_lo(zw.x), bf_hi(zw.x), bf_lo(zw.y), bf_hi(zw.y)}, z1 = {bf_lo(zw.z), bf_hi(zw.z), bf_lo(zw.w), bf_hi(zw.w)};
                    *(u32x4*)(A.y + gbase + (size_t)it * 8 * 512) = pack8(v0 * z0, v1 * z1);
                }
            }
        } else if (ATT_TEST & 2) {
            const int tid = wv * 64 + lane_now();
            const int bhd = (code - 2048u) >> 5, b = bhd >> 2, hd = bhd & 3;
            const size_t s0 = (size_t)(b * 8 + hd * 2) * SEQ * 64, s1 = s0 + (size_t)SEQ * 64;
            float* pk = A.park + (size_t)blockIdx.x * 32768 + tid * 64;
            f32x16 o[2][2];
            attn_pass<2, false>(L, A.qkv + 3 * SB + s0, A.qkv + 4 * SB + s0, A.qkv + 5 * SB + s0, A.qkv + 5 * SB + s1, nullptr, qb, o, tid, nullptr, -1.0f);
            { float* pk1 = pk; asm volatile("" : "+v"(pk1));
#pragma unroll
            for (int nv = 0; nv < 2; ++nv)
#pragma unroll
                for (int d0 = 0; d0 < 2; ++d0)
#pragma unroll
                    for (int j = 0; j < 4; ++j) { const f32x4 w = {o[nv][d0][4 * j], o[nv][d0][4 * j + 1], o[nv][d0][4 * j + 2], o[nv][d0][4 * j + 3]}; *(f32x4*)(pk1 + (nv * 2 + d0) * 16 + 4 * j) = w; }
            asm volatile("" ::: "memory"); }
            const int tid2_ = wv * 64 + lane_now();
            attn_pass<2, false>(L, A.qkv + 3 * SB + s1, A.qkv + 4 * SB + s1, A.qkv + 5 * SB + s0, A.qkv + 5 * SB + s1, nullptr, qb, o, tid2_, nullptr, -1.0f);
            f32x16 ss = f32x16{};
            const int lane2 = lane_now(), r32e = lane2 & 31, hie = lane2 >> 5;
            const float* pk2 = pk; asm volatile("" : "+v"(pk2));
#pragma unroll
            for (int nv = 0; nv < 2; ++nv)
#pragma unroll
                for (int d0 = 0; d0 < 2; ++d0) {
#pragma unroll
                    for (int j = 0; j < 4; ++j) { const f32x4 w = *(const f32x4*)(pk2 + (nv * 2 + d0) * 16 + 4 * j);
#pragma unroll
                        for (int i = 0; i < 4; ++i) { const int r = 4 * j + i; const float v = w[i] - A.lam * o[nv][d0][r]; o[nv][d0][r] = v; ss[r] += v * v; } }
                    asm volatile("" ::: "memory");
                }
#pragma unroll
            for (int r = 0; r < 16; ++r) { float s = ss[r]; s += xlane(s, lane2 ^ 1); s += xlane(s, lane2 ^ 2); s += xlane(s, lane2 ^ 4); s += xlane(s, lane2 ^ 8); s += xlane(s, lane2 ^ 16);
                ss[r] = 0.8f * __builtin_amdgcn_rsqf(s * (1.0f / 128.0f) + 1e-5f); }
            {
                LAS float* st = (LAS float*)(L + A_STAGE + wid * 8704);
                const int rsub = lane2 >> 3, c8 = (lane2 & 7) * 8;
                size_t gbase = (size_t)M * 512 + (size_t)(b * SEQ + q0w + rsub) * 512 + hd * 128 + c8; asm volatile("" : "+v"(gbase));
#pragma unroll
                for (int nv = 0; nv < 2; ++nv) {
#pragma unroll
                    for (int d0 = 0; d0 < 2; ++d0)
#pragma unroll
                        for (int r = 0; r < 16; ++r) st[((r & 3) + 8 * (r >> 2) + 4 * hie) * 68 + 32 * d0 + r32e] = o[nv][d0][r] * ss[r];
                    const f32x4 g0 = *(const f32x4*)(A.gsub + 64 * nv + c8), g1 = *(const f32x4*)(A.gsub + 64 * nv + c8 + 4);
#pragma unroll
                    for (int it = 0; it < 4; ++it) {
                        const f32x4 v0 = *(LAS f32x4*)(st + (it * 8 + rsub) * 68 + c8), v1 = *(LAS f32x4*)(st + (it * 8 + rsub) * 68 + c8 + 4);
                        const size_t gi = gbase + (size_t)it * 8 * 512 + 64 * nv;
                        const u32x4 zw = *(const u32x4*)(A.z + gi);
                        const f32x4 z0 = {bf_lo(zw.x), bf_hi(zw.x), bf_lo(zw.y), bf_hi(zw.y)}, z1 = {bf_lo(zw.z), bf_hi(zw.z), bf_lo(zw.w), bf_hi(zw.w)};
                        *(u32x4*)(A.y + gi) = pack8(v0 * g0 * z0, v1 * g1 * z1);
                    }
                    asm volatile("" ::: "memory");
                }
            }
        }
    }
    }
}

__device__ __forceinline__ int col_src(int n) {
    if (n >= 4096) return 4104 + (n - 4096);
    const int seg = n >> 9, c = n & 511;
    if (seg == 4 || seg == 5) { const int uu = c >> 6, p = c & 63, a = p >> 3, bb = p & 7; const int dim = bb < 4 ? 4 * a + bb : 32 + 4 * a + (bb - 4); return (seg == 4 ? 2056 : 2568) + uu * 64 + dim; }
    const int base = seg == 0 ? 0 : seg == 1 ? 512 : seg == 2 ? 1024 : seg == 3 ? 1544 : seg == 6 ? 3080 : 3592;
    return base + c;
}
template <bool MAP>
__device__ __forceinline__ void transpose_tile(LAS unsigned char* L, const float* __restrict__ src, int ld, int K, bf16_t* __restrict__ dst, int n0, int k0) {
    LAS float* ts = (LAS float*)L;
    const int tid = threadIdx.x, a = tid >> 6, c = tid & 63;
    const int sc = MAP ? col_src(n0 + c) : (n0 + c);
    float v[8];
#pragma unroll
    for (int p = 0; p < 8; ++p) v[p] = src[(size_t)(k0 + p * 8 + a) * ld + sc];
    __syncthreads();
#pragma unroll
    for (int p = 0; p < 8; ++p) ts[(p * 8 + a) * 65 + c] = v[p];
    __syncthreads();
#pragma unroll
    for (int p = 0; p < 8; ++p) { const int n = p * 8 + a; dst[(size_t)(n0 + n) * K + k0 + c] = bf16_1(ts[c * 65 + n]); }
}

struct P { const float* x; const float* g_pre; const float* w_in; const float* b_forget; const float* lq1; const float* lk1; const float* lq2; const float* lk2;
           const float* g_subln; const float* w_branch; const float* w_out; const float* g_post; float* out; unsigned char* ws; };

__device__ __forceinline__ void p0_prologue(LAS unsigned char* L, const P& p) {
    const int tid = threadIdx.x, lane = tid & 63, wid = tid >> 6;
    const int gtid = blockIdx.x * 512 + tid, gsz = gridDim.x * 512;
    unsigned char* ws = p.ws;
    float* ssq = (float*)(ws + WS_SSQ);
    for (int i = gtid; i < M; i += gsz) ssq[i] = 0.f;
    { float* kn2 = (float*)(ws + WS_KN2); for (int i = gtid; i < 64 * SEQ; i += gsz) kn2[i] = 0.f; }
    if (gtid < 8) ((unsigned*)(ws + WS_CTL))[32 * gtid] = 0u;
    if (gtid == 0) {
        float d1 = 0.f, d2 = 0.f;
        for (int i = 0; i < 64; ++i) { d1 += p.lq1[i] * p.lk1[i]; d2 += p.lq2[i] * p.lk2[i]; }
        ((float*)(ws + WS_CTL))[512] = expf(d1) - expf(d2) + 0.2f; }
    if (gtid < NITEMS) {
        unsigned* items = (unsigned*)(ws + WS_ITEMS); int rank; unsigned code;
        if (gtid < 1024) { const int qb = gtid >> 5, j = gtid & 31, c = 3 * (qb + 1); rank = 32 * (31 - qb) + 64 * (32 - c > 0 ? 32 - c : 0) + j; code = 2048u + (unsigned)(j * 32 + qb); }
        else { const int i2 = gtid - 1024, qb = i2 >> 6, j = i2 & 63, c = qb + 1; rank = 32 * (33 - (c + 2) / 3) + 64 * (32 - c) + j; code = (unsigned)(j * 32 + qb); }
        items[rank] = code;
    }
    {
        float* cs = (float*)(ws + WS_COS); float* sn = (float*)(ws + WS_SIN);
        for (int i = gtid; i < SEQ * 32; i += gsz) { const int s = i >> 5, f = i & 31;
            const double invf = exp2(-(double)f * (13.287712379549449 / 32.0));
            double rev = (double)s * invf * 0.15915494309189535; rev -= floor(rev);
            const float rf = (float)rev; cs[i] = __builtin_amdgcn_cosf(rf); sn[i] = __builtin_amdgcn_sinf(rf); }
    }
    for (int tt = blockIdx.x; tt < 2048; tt += gridDim.x) {
        if (tt < 1536) transpose_tile<true>(L, p.w_in, NIN, DM, (bf16_t*)(ws + WS_BT1), (tt >> 4) << 6, (tt & 15) << 6);
        else if (tt < 1792) { const int u = tt - 1536, br = u >> 7, v = u & 127;
            transpose_tile<false>(L, p.w_branch + (size_t)br * 512 * DM, DM, 512, (bf16_t*)(ws + WS_BT3A) + (size_t)br * DM * 512, (v >> 3) << 6, (v & 7) << 6); }
        else { const int u = tt - 1792; transpose_tile<false>(L, p.w_out, DM, DM, (bf16_t*)(ws + WS_BT3B), (u >> 4) << 6, (u & 15) << 6); }
    }
    {
        f32x4 gp[4]; float wf[4][4][8];
#pragma unroll
        for (int j = 0; j < 4; ++j) { gp[j] = *(const f32x4*)(p.g_pre + 4 * lane + 256 * j);
#pragma unroll
            for (int i = 0; i < 4; ++i) { const float* wp = p.w_in + (size_t)(4 * lane + 256 * j + i) * NIN + 1536; const f32x4 w0 = *(const f32x4*)wp, w1 = *(const f32x4*)(wp + 4);
                wf[j][i][0] = w0[0]; wf[j][i][1] = w0[1]; wf[j][i][2] = w0[2]; wf[j][i][3] = w0[3]; wf[j][i][4] = w1[0]; wf[j][i][5] = w1[1]; wf[j][i][6] = w1[2]; wf[j][i][7] = w1[3]; } }
        const int hh = (lane & 1) * 4 + ((lane >> 1) & 1) * 2 + ((lane >> 2) & 1);
        const float bfg = p.b_forget[hh];
        bf16_t* hb = (bf16_t*)(ws + WS_H); float* logf_ = (float*)(ws + WS_LOGF);
        const int rstep = gridDim.x * 8;
        int row = blockIdx.x * 8 + wid;
        f32x4 xv[4], xm[4], xn[4];
#pragma unroll
        for (int j = 0; j < 4; ++j) xv[j] = __builtin_nontemporal_load((const f32x4*)(p.x + (size_t)row * DM + 4 * lane + 256 * j));
        { const int r1 = row + rstep < M ? row + rstep : row;
#pragma unroll
          for (int j = 0; j < 4; ++j) xm[j] = __builtin_nontemporal_load((const f32x4*)(p.x + (size_t)r1 * DM + 4 * lane + 256 * j)); }
        for (; row < M; row += rstep) {
            const int rnext = row + 2 * rstep < M ? row + 2 * rstep : row;
#pragma unroll
            for (int j = 0; j < 4; ++j) xn[j] = __builtin_nontemporal_load((const f32x4*)(p.x + (size_t)rnext * DM + 4 * lane + 256 * j));
            float ss = 0.f;
#pragma unroll
            for (int j = 0; j < 4; ++j) ss += (xv[j][0] * xv[j][0] + xv[j][1] * xv[j][1]) + (xv[j][2] * xv[j][2] + xv[j][3] * xv[j][3]);
#pragma unroll
            for (int o = 1; o < 64; o <<= 1) ss += __shfl_xor(ss, o);
            const float rs = 1.0f / sqrtf(ss * (1.0f / 1024.0f) + 1e-6f);
            float fa[8] = {0.f, 0.f, 0.f, 0.f, 0.f, 0.f, 0.f, 0.f};
#pragma unroll
            for (int j = 0; j < 4; ++j) { const f32x4 hv = xv[j] * rs * gp[j];
                u32x2 w; w.x = pk_bf16(hv[0], hv[1]); w.y = pk_bf16(hv[2], hv[3]); *(u32x2*)(hb + (size_t)row * DM + 4 * lane + 256 * j) = w;
#pragma unroll
                for (int i = 0; i < 4; ++i)
#pragma unroll
                    for (int e = 0; e < 8; ++e) fa[e] += hv[i] * wf[j][i][e]; }
            float g4[4], g2[2], g1;
            { const bool up = (lane & 1) != 0;
#pragma unroll
              for (int k = 0; k < 4; ++k) { const float snd = up ? fa[k] : fa[k + 4]; const float rcv = __shfl_xor(snd, 1); g4[k] = (up ? fa[k + 4] : fa[k]) + rcv; } }
            { const bool up = (lane & 2) != 0;
#pragma unroll
              for (int k = 0; k < 2; ++k) { const float snd = up ? g4[k] : g4[k + 2]; const float rcv = __shfl_xor(snd, 2); g2[k] = (up ? g4[k + 2] : g4[k]) + rcv; } }
            { const bool up = (lane & 4) != 0; const float snd = up ? g2[0] : g2[1]; const float rcv = __shfl_xor(snd, 4); g1 = (up ? g2[1] : g2[0]) + rcv; }
            g1 += __shfl_xor(g1, 8); g1 += __shfl_xor(g1, 16); g1 += __shfl_xor(g1, 32);
            if (lane < 8) { const float zf = g1 + bfg; const float ls = fminf(zf, 0.f) - log1pf(expf(-fabsf(zf)));
                logf_[(size_t)((row >> 13) * 8 + hh) * SEQ + (row & (SEQ - 1))] = ls; }
#pragma unroll
            for (int j = 0; j < 4; ++j) { xv[j] = xm[j]; xm[j] = xn[j]; }
        }
    }
}

__device__ __forceinline__ void cumsum_seq(LAS unsigned char* L, const float* __restrict__ lf, float* __restrict__ cb, const int wv) {
    const int lane = lane_now(), wid = wv, tid = wv * 64 + lane;
    LAS float* wt = (LAS float*)L;
    f32x4 v[4]; float run = 0.f;
#pragma unroll
    for (int j = 0; j < 4; ++j) { v[j] = *(const f32x4*)(lf + tid * 16 + 4 * j);
#pragma unroll
        for (int i = 0; i < 4; ++i) { run += v[j][i]; v[j][i] = run; } }
    float sc = run;
#pragma unroll
    for (int o = 1; o < 64; o <<= 1) { const float n = __shfl_up(sc, o); if (lane >= o) sc += n; }
    __syncthreads();
    if (lane == 63) wt[wid] = sc;
    __syncthreads();
    float pre = sc - run;
    for (int w = 0; w < wid; ++w) pre += wt[w];
#pragma unroll
    for (int j = 0; j < 4; ++j) { f32x4 r;
#pragma unroll
        for (int i = 0; i < 4; ++i) r[i] = -(pre + v[j][i]) * LOG2E;
        *(f32x4*)(cb + tid * 16 + 4 * j) = r; }
    __syncthreads();
}

__global__ void __launch_bounds__(512) fwd_megakernel(P p) {
    extern __shared__ __attribute__((aligned(16))) unsigned char lds_raw[];
    LAS unsigned char* L = (LAS unsigned char*)lds_raw;
    cg::grid_group grid = cg::this_grid();
    unsigned char* ws = p.ws;
    const int G = gridDim.x, c = blockIdx.x;
    const int wv = __builtin_amdgcn_readfirstlane(threadIdx.x >> 6);
    bf16_t* qkv = (bf16_t*)(ws + WS_QKV); bf16_t* zbuf = (bf16_t*)(ws + WS_Z); bf16_t* gbuf = (bf16_t*)(ws + WS_G);

#ifndef PHM
#define PHM 63
#endif
    if (PHM & 1) p0_prologue(L, p);
    grid.sync();

    if ((PHM & 2) && c < 64) cumsum_seq(L, (const float*)(ws + WS_LOGF) + (size_t)c * SEQ, (float*)(ws + WS_CB) + (size_t)c * SEQ, wv);
    if (PHM & 2) {
        pg8::Gemm g{(const bf16_t*)(ws + WS_H), (const bf16_t*)(ws + WS_BT1), M, N1, DM}; pg8::StaticOrder S; S.init(M, N1, G, c);
        Epi1 E{qkv, zbuf, gbuf, (const float*)(ws + WS_COS), (const float*)(ws + WS_SIN), (float*)(ws + WS_KN2)};
        pg8::gemm_phase<Epi1, pg8::StaticOrder, true, true>(L, g, S, E, wv);
    }
    grid.sync();

    if (PHM & 4) {
        const float lam = ((const float*)(ws + WS_CTL))[512];
        AttnArgs A{qkv, (const float*)(ws + WS_CB), zbuf, (bf16_t*)(ws + WS_Y), (float*)(ws + WS_PARK), (const float*)(ws + WS_KN2), (unsigned*)(ws + WS_CTL), p.g_subln, lam};
        attn_phase(L, A, wv);
    }
    grid.sync();

    if (PHM & 8) {
        pg8::Gemm g{(const bf16_t*)(ws + WS_Y), (const bf16_t*)(ws + WS_BT3A), 2 * M, 2 * DM, 512}; Sched3a S; S.so.init(M, DM, G, c);
        Epi3a E{gbuf, (bf16_t*)(ws + WS_T), (bf16_t*)(ws + WS_MERGED)};
        pg8::gemm_phase<Epi3a, Sched3a, true, true>(L, g, S, E, wv);
    }
    grid.sync();

    if (PHM & 16) {
        pg8::Gemm g{(const bf16_t*)(ws + WS_MERGED), (const bf16_t*)(ws + WS_BT3B), M, DM, DM}; pg8::StaticOrder S; S.init(M, DM, G, c);
        Epi3b E{(bf16_t*)(ws + WS_Z), (float*)(ws + WS_SSQ)};
        pg8::gemm_phase<Epi3b, pg8::StaticOrder, true, true>(L, g, S, E, wv);
    }
    grid.sync();

    if (PHM & 32) {
        const float* ssq = (const float*)(ws + WS_SSQ);
        const int t4_ = wv * 64 + lane_now();
        const int gtid = c * 512 + t4_, gsz = G * 512;
        for (int i = gtid; i < M * 256; i += gsz) {
            const int row = i >> 8, c4 = i & 255;
            const u32x2 yw = *(const u32x2*)((const bf16_t*)(ws + WS_Z) + (size_t)i * 4); const f32x4 yv = {bf_lo(yw.x), bf_hi(yw.x), bf_lo(yw.y), bf_hi(yw.y)};
            const f32x4 xv = *(const f32x4*)(p.x + (size_t)i * 4), gv = *(const f32x4*)(p.g_post + c4 * 4);
            const float rs = 1.0f / sqrtf(ssq[row] * (1.0f / 1024.0f) + 1e-6f);
            *(f32x4*)(p.out + (size_t)i * 4) = xv + yv * rs * gv;
        }
    }
}
}

extern "C" void kernel_launch(void* const* d_in, const int* in_sizes, int n_in, void* d_out, int out_size, void* d_ws, size_t ws_size, hipStream_t stream) {
    static int grid = 0;
    if (grid == 0) {
        if (n_in != 12 || ws_size < mk::WS_END) { fprintf(stderr, "kernel_launch: unexpected n_in %d / ws_size %zu\n", n_in, ws_size); grid = -1; return; }
        int dev = 0, cus = 0, per_cu = 0;
        hipGetDevice(&dev); hipDeviceGetAttribute(&cus, hipDeviceAttributeMultiprocessorCount, dev);
        if (hipFuncSetAttribute((const void*)mk::fwd_megakernel, hipFuncAttributeMaxDynamicSharedMemorySize, mk::LDS_BYTES) != hipSuccess) { fprintf(stderr, "kernel_launch: hipFuncSetAttribute failed\n"); grid = -1; return; }
        if (hipOccupancyMaxActiveBlocksPerMultiprocessor(&per_cu, (const void*)mk::fwd_megakernel, 512, mk::LDS_BYTES) != hipSuccess || per_cu < 1) { fprintf(stderr, "kernel_launch: occupancy query says %d\n", per_cu); per_cu = 1; }
        (void)hipGetLastError();
        grid = cus;
    }
    if (grid < 0) return;
    mk::P p{};
    p.x = (const float*)d_in[0]; p.g_pre = (const float*)d_in[1]; p.w_in = (const float*)d_in[2]; p.b_forget = (const float*)d_in[3];
    p.lq1 = (const float*)d_in[4]; p.lk1 = (const float*)d_in[5]; p.lq2 = (const float*)d_in[6]; p.lk2 = (const float*)d_in[7];
    p.g_subln = (const float*)d_in[8]; p.w_branch = (const float*)d_in[9]; p.w_out = (const float*)d_in[10]; p.g_post = (const float*)d_in[11];
    p.out = (float*)d_out; p.ws = (unsigned char*)d_ws;
    void* args[] = {&p};
    hipError_t e = hipLaunchCooperativeKernel((const void*)mk::fwd_megakernel, dim3(grid), dim3(512), args, mk::LDS_BYTES, stream);
    if (e != hipSuccess) fprintf(stderr, "cooperative launch failed: %s (grid %d)\n", hipGetErrorString(e), grid);
}
```

```cpp
#include <hip/hip_runtime.h>
#include <hip/hip_cooperative_groups.h>
#include <cstdio>
#include <cstdint>
namespace cg = cooperative_groups;
namespace pg8 {
#define PG8_LAS __attribute__((address_space(3)))
typedef unsigned short bf16_t;
typedef short bf16x8 __attribute__((ext_vector_type(8)));
typedef float f32x4 __attribute__((ext_vector_type(4)));
typedef unsigned u32x4 __attribute__((ext_vector_type(4)));
constexpr int BM = 256, BK = 64, HALF = 128, HTB = HALF * BK * 2  , STAGE_BYTES = 8 * HTB, NXCD = 8, WGM = 4;

__host__ __device__ __forceinline__ int lds_byte(int r, int c) { const int st = (r >> 4) * 2 + (c >> 5), rr = r & 15, cc = c & 31, ob = rr * 64 + cc * 2; return st * 1024 + (ob ^ (((ob >> 9) & 1) << 5)); }
__host__ __device__ __forceinline__ void stage_rc(int b, int& R, int& C) { const int st = b / 1024, sb = b % 1024, swz = sb ^ (((sb >> 9) & 1) << 5); R = (st >> 1) * 16 + swz / 64; C = (st & 1) * 32 + (swz % 64) / 2; }
__host__ __device__ __forceinline__ int perm32(int rho) { const int n = rho >> 4, i = rho & 15; return 8 * (i >> 2) + 4 * n + (i & 3); }

struct Unit { int pm, pn; };
struct Gemm { const bf16_t* A; const bf16_t* Bt; int M, N, K; };

struct StaticOrder {
    int nM, nN, nwg, G, c;
    __host__ __device__ void init(int M, int N, int G_, int c_) { nM = M / BM; nN = N / BM; nwg = nM * nN; G = G_; c = c_; }
    __host__ __device__ bool next(int i, Unit& u) const {
        const long L = (long)i * G + c; if (L >= nwg) return false;
        int wgid = (int)L; { const int q = nwg / NXCD, r = nwg % NXCD, xcd = wgid % NXCD, off = wgid / NXCD; wgid = (xcd < r ? xcd * (q + 1) : r * (q + 1) + (xcd - r) * q) + off; }
        const int nig = WGM * nN, gid = wgid / nig, fm = gid * WGM, gsz = (nM - fm) < WGM ? (nM - fm) : WGM;
        u.pm = fm + ((wgid % nig) % gsz); u.pn = (wgid % nig) / gsz; return true;
    }
    __device__ __forceinline__ void a_ready(const Unit&) const {}
    __device__ __forceinline__ void done(const Unit&) const {}
};

__device__ __forceinline__ unsigned cvt_pk_bf16(float lo, float hi) { unsigned r; asm volatile("v_cvt_pk_bf16_f32 %0, %1, %2" : "=v"(r) : "v"(lo), "v"(hi)); return r; }
typedef float f32x2 __attribute__((ext_vector_type(2)));
__device__ __forceinline__ f32x2 gelu_pk(f32x2 v) {
    const f32x2 av = __builtin_elementwise_abs(v), d = av * 0.2316418882f + 1.0f;
    f32x2 t; t.x = __builtin_amdgcn_rcpf(d.x); t.y = __builtin_amdgcn_rcpf(d.y);
    f32x2 q = t * 0.5307027145f + (-0.7265760135f); q = q * t + 0.7107068705f; q = q * t + (-0.142248368f); q = q * t + 0.127414796f; q = q * t;
    const f32x2 s = (v * v) * (-0.72134752044f);
    f32x2 e; e.x = __builtin_amdgcn_exp2f(s.x); e.y = __builtin_amdgcn_exp2f(s.y);
    const f32x2 m = v * (q * e), r = v - m;
    f32x2 o; o.x = v.x < 0.f ? m.x : r.x; o.y = v.y < 0.f ? m.y : r.y; return o;
}

template <int ACT  > struct EpiBf16 {
    static constexpr bool PERM = true, AFTER_DRAIN = false; static_assert(ACT == 0 || ACT == 1, "EpiBf16: ACT is 0 (none) or 1 (gelu_pk)");
    bf16_t* O; int ldc; const float* bias; int split_cols; size_t split_stride; float scale0;
    __device__ __forceinline__ void operator()(const f32x4 (&acc)[2][2][4][2], const Unit& u, int wr, int wc, int fr, int fq) const {
        const int row0 = u.pm * BM + wr * 64 + fr; int colt = u.pn * BM; bf16_t* base = O;
        float sc = 1.f; if (split_cols) { const int t = colt / split_cols; base += (size_t)t * split_stride; colt -= t * split_cols; if (t == 0) sc = scale0; }
        const int col0 = colt + wc * 32 + 8 * fq, bcol0 = u.pn * BM + wc * 32 + 8 * fq;
        f32x4 bv[2][2];
#pragma unroll
        for (int bj = 0; bj < 2; ++bj)
#pragma unroll
            for (int n = 0; n < 2; ++n) bv[bj][n] = bias ? *(const f32x4*)(bias + bcol0 + bj * HALF + 4 * n) : (f32x4){0.f, 0.f, 0.f, 0.f};
#pragma unroll
        for (int ai = 0; ai < 2; ++ai)
#pragma unroll
            for (int m = 0; m < 4; ++m) { bf16_t* rowp = base + (size_t)(row0 + ai * HALF + m * 16) * ldc + col0;
#pragma unroll
                for (int bj = 0; bj < 2; ++bj) { f32x4 v0 = acc[ai][bj][m][0] + bv[bj][0], v1 = acc[ai][bj][m][1] + bv[bj][1];
                    if (ACT == 1) { f32x2 a = gelu_pk((f32x2){v0[0], v0[1]}), b = gelu_pk((f32x2){v0[2], v0[3]}), c = gelu_pk((f32x2){v1[0], v1[1]}), d = gelu_pk((f32x2){v1[2], v1[3]});
                        v0 = (f32x4){a.x, a.y, b.x, b.y}; v1 = (f32x4){c.x, c.y, d.x, d.y}; }
                    v0 = v0 * sc; v1 = v1 * sc; u32x4 w; w.x = cvt_pk_bf16(v0[0], v0[1]); w.y = cvt_pk_bf16(v0[2], v0[3]); w.z = cvt_pk_bf16(v1[0], v1[1]); w.w = cvt_pk_bf16(v1[2], v1[3]);
                    *(u32x4*)(rowp + bj * HALF) = w; } }
    }
};

template <class Epi, class Sched, bool ALIGN_EPI = false, bool SP2 = false>
__device__ __forceinline__ void gemm_phase(PG8_LAS unsigned char* lds, const Gemm g, const Sched& S, const Epi& E, const int wv  ) {
    int lane_; asm volatile("v_mbcnt_lo_u32_b32 %0, -1, 0\n\tv_mbcnt_hi_u32_b32 %0, -1, %0" : "=v"(lane_));
    const int tid_ = wv * 64 + lane_;
    const int tid = tid_, wid = __builtin_amdgcn_readfirstlane(tid >> 6), lane = tid & 63, wr = wid >> 2, wc = wid & 3, fr = lane & 15, fq = lane >> 4;
    const int K = g.K, nt = K / BK;
    unsigned voffA[2], voffB[2];
#pragma unroll
    for (int i = 0; i < 2; ++i) { int R, C; stage_rc(tid * 16 + i * 8192, R, C); const int Rb = Epi::PERM ? ((R & ~31) + perm32(R & 31)) : R;
        voffA[i] = (unsigned)(R * K + C) * 2u; voffB[i] = (unsigned)(Rb * K + C) * 2u; }
    const size_t kstep = (size_t)(BK * 2);
    const size_t hstep = (size_t)HALF * K * 2;
    const size_t tstep = 2 * hstep;
    const unsigned ldsw = (unsigned)wid * 1024u;
    const int aoff = lds_byte(wr * 64 + fr, fq * 8), boff = lds_byte(wc * 32 + fr, fq * 8);
#define PG8_SA(b, h) (((b) * 2 + (h)) * HTB)
#define PG8_SB(b, h) ((4 + (b) * 2 + (h)) * HTB)
#define PG8_STAGE(bufoff, gbase, voff) do { _Pragma("unroll") for (int _i = 0; _i < 2; ++_i) \
        __builtin_amdgcn_global_load_lds((const unsigned*)((const char*)(gbase) + (voff)[_i]), (PG8_LAS unsigned*)(lds + (bufoff) + ldsw + _i * 8192), 16, 0, 0); } while (0)
#define PG8_LDA(dst, b, h) do { _Pragma("unroll") for (int m = 0; m < 4; ++m) _Pragma("unroll") for (int k = 0; k < 2; ++k) dst[m][k] = *(const PG8_LAS bf16x8*)(lds + PG8_SA(b, h) + aoff + m * 2048 + k * 1024); } while (0)
#define PG8_LDB(dst, b, h) do { _Pragma("unroll") for (int n = 0; n < 2; ++n) _Pragma("unroll") for (int k = 0; k < 2; ++k) dst[n][k] = *(const PG8_LAS bf16x8*)(lds + PG8_SB(b, h) + boff + n * 2048 + k * 1024); } while (0)
#define PG8_MMA(ai, bj, At, Bt) do { __builtin_amdgcn_s_setprio(1); _Pragma("unroll") for (int m = 0; m < 4; ++m) _Pragma("unroll") for (int n = 0; n < 2; ++n) _Pragma("unroll") for (int k = 0; k < 2; ++k) \
        acc[ai][bj][m][n] = __builtin_amdgcn_mfma_f32_16x16x32_bf16(Bt[n][k], At[m][k], acc[ai][bj][m][n], 0, 0, 0); __builtin_amdgcn_s_setprio(0); } while (0)
#define PG8_WAIT_V(n) asm volatile("s_waitcnt vmcnt(" #n ")" ::: "memory")
#define PG8_WAIT_L(n) asm volatile("s_waitcnt lgkmcnt(" #n ")" ::: "memory")
#define PG8_BAR __builtin_amdgcn_s_barrier()
#define PG8_SCHED __builtin_amdgcn_sched_barrier(0)
    Unit cur, nxt; int ui = 0;
    if (!S.next(0, cur)) return;
    f32x4 acc[2][2][4][2];
#pragma unroll
    for (int a = 0; a < 2; ++a)
#pragma unroll
        for (int b = 0; b < 2; ++b)
#pragma unroll
            for (int m = 0; m < 4; ++m)
#pragma unroll
                for (int n = 0; n < 2; ++n) acc[a][b][m][n] = (f32x4){0.f, 0.f, 0.f, 0.f};
    bf16x8 At[4][2], B0[2][2], B1[2][2];
    const char* cA = (const char*)g.A + (size_t)cur.pm * tstep; const char* cB = (const char*)g.Bt + (size_t)cur.pn * tstep;
    S.a_ready(cur);
    if constexpr (SP2) {
        PG8_STAGE(PG8_SB(0, 0), cB, voffB); PG8_STAGE(PG8_SB(0, 1), cB + hstep, voffB); PG8_STAGE(PG8_SA(0, 0), cA, voffA); PG8_STAGE(PG8_SA(0, 1), cA + hstep, voffA);
        if (wr == 1) PG8_BAR;
        PG8_WAIT_V(2); PG8_BAR;
        PG8_STAGE(PG8_SB(1, 0), cB + kstep, voffB); PG8_STAGE(PG8_SA(1, 0), cA + kstep, voffA); PG8_STAGE(PG8_SB(1, 1), cB + hstep + kstep, voffB);
        PG8_WAIT_V(6); PG8_BAR;
    } else {
        PG8_STAGE(PG8_SB(0, 0), cB, voffB); PG8_STAGE(PG8_SA(0, 0), cA, voffA); PG8_STAGE(PG8_SB(0, 1), cB + hstep, voffB); PG8_STAGE(PG8_SA(0, 1), cA + hstep, voffA);
        if (wr == 1) PG8_BAR;
        PG8_WAIT_V(4); PG8_BAR;
        PG8_STAGE(PG8_SB(1, 0), cB + kstep, voffB); PG8_STAGE(PG8_SA(1, 0), cA + kstep, voffA); PG8_STAGE(PG8_SB(1, 1), cB + hstep + kstep, voffB);
        PG8_WAIT_V(6); PG8_BAR;
    }
    for (;;) {
        const bool has_next = S.next(ui + 1, nxt);
        const char* nA = has_next ? (const char*)g.A + (size_t)nxt.pm * tstep : cA; const char* nB = has_next ? (const char*)g.Bt + (size_t)nxt.pn * tstep : cB;
        for (int t = 0; t < nt; t += 2) {
            const bool last = (t == nt - 2);
            const char* a1 = cA + (size_t)(t + 1) * kstep;
            const char* a2 = last ? nA : cA + (size_t)(t + 2) * kstep; const char* b2 = last ? nB : cB + (size_t)(t + 2) * kstep;
            const char* a3 = a2 + kstep; const char* b3 = b2 + kstep;
            if (last && has_next) S.a_ready(nxt);
            if constexpr (SP2) {
            PG8_LDB(B0, 0, 0); PG8_LDB(B1, 0, 1); PG8_SCHED; PG8_LDA(At, 0, 0); PG8_STAGE(PG8_SA(1, 1), a1 + hstep, voffA);
            PG8_WAIT_V(8); PG8_WAIT_L(0); PG8_BAR; PG8_MMA(0, 0, At, B0); PG8_MMA(0, 1, At, B1); PG8_BAR; PG8_SCHED;
            PG8_LDA(At, 0, 1); PG8_STAGE(PG8_SB(0, 0), b2, voffB); PG8_STAGE(PG8_SB(0, 1), b2 + hstep, voffB); PG8_STAGE(PG8_SA(0, 0), a2, voffA);
            PG8_WAIT_V(8); PG8_WAIT_L(0); PG8_BAR; PG8_MMA(1, 0, At, B0); PG8_MMA(1, 1, At, B1); PG8_BAR; PG8_SCHED;
            PG8_LDB(B0, 1, 0); PG8_LDB(B1, 1, 1); PG8_SCHED; PG8_LDA(At, 1, 0); PG8_STAGE(PG8_SA(0, 1), a2 + hstep, voffA);
            PG8_WAIT_V(8); PG8_WAIT_L(0); PG8_BAR; PG8_MMA(0, 0, At, B0); PG8_MMA(0, 1, At, B1); PG8_BAR; PG8_SCHED;
            PG8_LDA(At, 1, 1); PG8_STAGE(PG8_SB(1, 0), b3, voffB); PG8_STAGE(PG8_SB(1, 1), b3 + hstep, voffB); PG8_STAGE(PG8_SA(1, 0), a3, voffA);
            PG8_WAIT_V(8); PG8_WAIT_L(0); PG8_BAR; PG8_MMA(1, 0, At, B0); PG8_MMA(1, 1, At, B1); PG8_BAR; PG8_SCHED;
            } else {
            PG8_LDB(B0, 0, 0); PG8_SCHED; PG8_LDA(At, 0, 0); PG8_STAGE(PG8_SA(1, 1), a1 + hstep, voffA);
            PG8_WAIT_L(8); PG8_BAR; PG8_WAIT_L(0); PG8_MMA(0, 0, At, B0); PG8_BAR; PG8_SCHED;
            PG8_LDB(B1, 0, 1); PG8_STAGE(PG8_SB(0, 0), b2, voffB);
            PG8_BAR; PG8_WAIT_L(0); PG8_MMA(0, 1, At, B1); PG8_BAR;
            PG8_LDA(At, 0, 1); PG8_STAGE(PG8_SA(0, 0), a2, voffA);
            PG8_BAR; PG8_WAIT_L(0); PG8_MMA(1, 0, At, B0); PG8_BAR; PG8_SCHED;
            PG8_STAGE(PG8_SB(0, 1), b2 + hstep, voffB);
            PG8_WAIT_V(6); PG8_BAR; PG8_MMA(1, 1, At, B1); PG8_BAR;
            PG8_LDB(B0, 1, 0); PG8_SCHED; PG8_LDA(At, 1, 0); PG8_STAGE(PG8_SA(0, 1), a2 + hstep, voffA);
            PG8_WAIT_L(8); PG8_BAR; PG8_WAIT_L(0); PG8_MMA(0, 0, At, B0); PG8_BAR; PG8_SCHED;
            PG8_LDB(B1, 1, 1); PG8_STAGE(PG8_SB(1, 0), b3, voffB);
            PG8_BAR; PG8_WAIT_L(0); PG8_MMA(0, 1, At, B1); PG8_BAR;
            PG8_LDA(At, 1, 1); PG8_STAGE(PG8_SA(1, 0), a3, voffA);
            PG8_BAR; PG8_WAIT_L(0); PG8_MMA(1, 0, At, B0); PG8_BAR; PG8_SCHED;
            PG8_STAGE(PG8_SB(1, 1), b3 + hstep, voffB);
            PG8_WAIT_V(6); PG8_BAR; PG8_MMA(1, 1, At, B1); PG8_BAR;
            }
        }
        if constexpr (ALIGN_EPI) { if (wr == 0) PG8_BAR; }
        if constexpr (!Epi::AFTER_DRAIN) { E(acc, cur, wr, wc, fr, fq); S.done(cur); }
        if (!has_next) break;
#pragma unroll
        for (int a = 0; a < 2; ++a)
#pragma unroll
            for (int b = 0; b < 2; ++b)
#pragma unroll
                for (int m = 0; m < 4; ++m)
#pragma unroll
                    for (int n = 0; n < 2; ++n) acc[a][b][m][n] = (f32x4){0.f, 0.f, 0.f, 0.f};
        cur = nxt; cA = nA; cB = nB; ++ui;
        if constexpr (ALIGN_EPI) { if (wr == 1) PG8_BAR; }
    }
    PG8_WAIT_V(0);
    if constexpr (!ALIGN_EPI) { if (wr == 0) PG8_BAR; }
    PG8_BAR;
    if constexpr (Epi::AFTER_DRAIN) { E.fused(acc, cur, wr, wc, fr, fq, lds, wid, lane); S.done(cur); }
#undef PG8_SA
#undef PG8_SB
#undef PG8_STAGE
#undef PG8_LDA
#undef PG8_LDB
#undef PG8_MMA
#undef PG8_WAIT_V
#undef PG8_WAIT_L
#undef PG8_BAR
#undef PG8_SCHED
}
}

#define LAS __attribute__((address_space(3)))
namespace mk {
using pg8::bf16_t; using pg8::f32x4; using pg8::u32x4; using pg8::Unit;
typedef short bf16x8 __attribute__((ext_vector_type(8)));
typedef short s16x4 __attribute__((ext_vector_type(4)));
typedef float f32x16 __attribute__((ext_vector_type(16)));
typedef unsigned u32x2 __attribute__((ext_vector_type(2)));

constexpr int M = 65536, DM = 1024, SEQ = 8192, NBATCH = 8, NIN = 6152, N1 = 6144, NITEMS = 3072;
constexpr size_t MiB = (size_t)1 << 20;
constexpr size_t WS_CTL = 0, WS_BT1 = 1 * MiB, WS_BT3A = 13 * MiB, WS_BT3B = 15 * MiB, WS_COS = 17 * MiB, WS_SIN = 18 * MiB, WS_LOGF = 19 * MiB, WS_CB = 21 * MiB,
                 WS_SSQ = 23 * MiB, WS_PARK = 24 * MiB, WS_ITEMS = 56 * MiB, WS_KN2 = 57 * MiB, WS_G = 64 * MiB, WS_QKV = 320 * MiB, WS_Z = 704 * MiB, WS_H = 832 * MiB, WS_Y = WS_H,
                 WS_T = 320 * MiB, WS_MERGED = 576 * MiB, WS_END = 960 * MiB;
constexpr size_t SB = (size_t)NBATCH * 8 * SEQ * 64;
constexpr float C2 = 0.125f * 1.4426950408889634f;
constexpr float LOG2E = 1.4426950408889634f;
constexpr int LDS_BYTES = 131072 + 256;

__device__ __forceinline__ unsigned pk_bf16(float lo, float hi) {
    typedef float f32x2_t __attribute__((ext_vector_type(2))); typedef __bf16 bf16x2_t __attribute__((ext_vector_type(2)));
    f32x2_t v = {lo, hi}; bf16x2_t b = __builtin_convertvector(v, bf16x2_t); return __builtin_bit_cast(unsigned, b); }
__device__ __forceinline__ bf16_t bf16_1(float v) { return (bf16_t)(pk_bf16(v, 0.f) & 0xffffu); }
__device__ __forceinline__ float bf_lo(unsigned w) { return __uint_as_float(w << 16); }
__device__ __forceinline__ float bf_hi(unsigned w) { return __uint_as_float(w & 0xffff0000u); }
__device__ __forceinline__ float bf1(bf16_t v) { return __uint_as_float((unsigned)v << 16); }
__device__ __forceinline__ float sigmoid_(float v) { return __builtin_amdgcn_rcpf(1.f + __expf(-v)); }
__device__ __forceinline__ float silu_(float v) { return v * sigmoid_(v); }
__device__ __forceinline__ u32x4 pack8(const f32x4 a, const f32x4 b) { u32x4 w; w.x = pk_bf16(a[0], a[1]); w.y = pk_bf16(a[2], a[3]); w.z = pk_bf16(b[0], b[1]); w.w = pk_bf16(b[2], b[3]); return w; }

struct Epi1 {
    static constexpr bool PERM = true, AFTER_DRAIN = false;
    bf16_t* qkv; bf16_t* z; bf16_t* g; const float* cs; const float* sn; float* kn2;
    __device__ __forceinline__ void operator()(const f32x4 (&acc)[2][2][4][2], const Unit& u, int wr, int wc, int fr, int fq) const {
        const int pn = u.pn; const int row0 = u.pm * 256 + wr * 64 + fr; const int ct = wc * 32 + 8 * fq;
        if (pn >= 16) {
#pragma unroll
            for (int ai = 0; ai < 2; ++ai)
#pragma unroll
                for (int m = 0; m < 4; ++m) { const int row = row0 + ai * 128 + m * 16; bf16_t* rp = g + (size_t)row * 2048 + (pn - 16) * 256 + ct;
#pragma unroll
                    for (int bj = 0; bj < 2; ++bj) { f32x4 v0 = acc[ai][bj][m][0], v1 = acc[ai][bj][m][1];
#pragma unroll
                        for (int i = 0; i < 4; ++i) { v0[i] = sigmoid_(v0[i]); v1[i] = sigmoid_(v1[i]); }
                        *(u32x4*)(rp + bj * 128) = pack8(v0, v1); } }
        } else if ((pn & 7) >= 6) {
            bf16_t* zz = z + (pn >= 8 ? (size_t)M * 512 : (size_t)0);
#pragma unroll
            for (int ai = 0; ai < 2; ++ai)
#pragma unroll
                for (int m = 0; m < 4; ++m) { const int row = row0 + ai * 128 + m * 16; bf16_t* rp = zz + (size_t)row * 512 + (pn & 1) * 256 + ct;
#pragma unroll
                    for (int bj = 0; bj < 2; ++bj) { f32x4 v0 = acc[ai][bj][m][0], v1 = acc[ai][bj][m][1];
#pragma unroll
                        for (int i = 0; i < 4; ++i) { v0[i] = silu_(v0[i]); v1[i] = silu_(v1[i]); }
                        *(u32x4*)(rp + bj * 128) = pack8(v0, v1); } }
        } else if (pn >= 8 && pn < 12) {
            bf16_t* buf = qkv + (size_t)(pn < 10 ? 3 : 4) * SB; const float sc = pn < 10 ? C2 : 1.f;
#pragma unroll
            for (int ai = 0; ai < 2; ++ai)
#pragma unroll
                for (int m = 0; m < 4; ++m) { const int row = row0 + ai * 128 + m * 16; const int b = row >> 13, s = row & (SEQ - 1);
#pragma unroll
                    for (int bj = 0; bj < 2; ++bj) { const int colp = (pn & 1) * 256 + bj * 128 + ct; const int strm = colp >> 6, a = (colp & 63) >> 3;
                        const f32x4 c4 = *(const f32x4*)(cs + s * 32 + 4 * a), s4 = *(const f32x4*)(sn + s * 32 + 4 * a);
                        const f32x4 v0 = acc[ai][bj][m][0], v1 = acc[ai][bj][m][1];
                        const f32x4 lo = (v0 * c4 - v1 * s4) * sc, hi = (v1 * c4 + v0 * s4) * sc;
                        bf16_t* dst = buf + ((size_t)(b * 8 + strm) * SEQ + s) * 64 + 4 * a;
                        u32x2 w0, w1; w0.x = pk_bf16(lo[0], lo[1]); w0.y = pk_bf16(lo[2], lo[3]); w1.x = pk_bf16(hi[0], hi[1]); w1.y = pk_bf16(hi[2], hi[3]);
                        *(u32x2*)dst = w0; *(u32x2*)(dst + 32) = w1; } }
        } else {
            bf16_t* buf = qkv + (size_t)(pn >= 12 ? 5 : (pn >> 1)) * SB; const float sc = pn < 2 ? C2 : 1.f;
#pragma unroll
            for (int ai = 0; ai < 2; ++ai)
#pragma unroll
                for (int m = 0; m < 4; ++m) { const int row = row0 + ai * 128 + m * 16; const int b = row >> 13, s = row & (SEQ - 1);
#pragma unroll
                    for (int bj = 0; bj < 2; ++bj) { const int colp = (pn & 1) * 256 + bj * 128 + ct; const int strm = colp >> 6, d = colp & 63;
                        const f32x4 v0 = acc[ai][bj][m][0] * sc, v1 = acc[ai][bj][m][1] * sc;
                        *(u32x4*)(buf + ((size_t)(b * 8 + strm) * SEQ + s) * 64 + d) = pack8(v0, v1);
                        if (pn == 2 || pn == 3) {
                            float ps = (v0[0] * v0[0] + v0[1] * v0[1]) + (v0[2] * v0[2] + v0[3] * v0[3]) + (v1[0] * v1[0] + v1[1] * v1[1]) + (v1[2] * v1[2] + v1[3] * v1[3]);
                            ps += __shfl_xor(ps, 16); ps += __shfl_xor(ps, 32);
                            if (fq == 0) atomicAdd(kn2 + (size_t)(b * 8 + strm) * SEQ + s, ps); } } }
        }
    }
};

struct Sched3a {
    pg8::StaticOrder so;
    __device__ bool next(int i, Unit& u) const { if (!so.next(i >> 1, u)) return false; const int br = i & 1; u.pm += 256 * br; u.pn += 4 * br; return true; }
    __device__ __forceinline__ void a_ready(const Unit&) const {}
    __device__ __forceinline__ void done(const Unit&) const {}
};
struct Epi3a {
    static constexpr bool PERM = true, AFTER_DRAIN = false;
    const bf16_t* g; bf16_t* T; bf16_t* merged;
    __device__ __forceinline__ void operator()(const f32x4 (&acc)[2][2][4][2], const Unit& u, int wr, int wc, int fr, int fq) const {
        const int br = u.pm >= 256 ? 1 : 0; const int pm = u.pm - 256 * br, pn = u.pn - 4 * br;
        const int row0 = pm * 256 + wr * 64 + fr; const int col0 = pn * 256 + wc * 32 + 8 * fq;
#pragma unroll
        for (int ai = 0; ai < 2; ++ai)
#pragma unroll
            for (int m = 0; m < 4; ++m) { const int row = row0 + ai * 128 + m * 16;
#pragma unroll
                for (int bj = 0; bj < 2; ++bj) { const int col = col0 + bj * 128;
                    const u32x4 gw = *(const u32x4*)(g + (size_t)row * 2048 + br * 1024 + col);
                    const f32x4 g0 = {bf_lo(gw.x), bf_hi(gw.x), bf_lo(gw.y), bf_hi(gw.y)}, g1 = {bf_lo(gw.z), bf_hi(gw.z), bf_lo(gw.w), bf_hi(gw.w)};
                    bf16_t* tp = T + (size_t)row * 1024 + col;
                    if (br == 0) { *(u32x4*)tp = pack8(g0 * acc[ai][bj][m][0], g1 * acc[ai][bj][m][1]); }
                    else { const u32x4 tw = *(const u32x4*)tp;
                        const f32x4 t0 = {bf_lo(tw.x), bf_hi(tw.x), bf_lo(tw.y), bf_hi(tw.y)}, t1 = {bf_lo(tw.z), bf_hi(tw.z), bf_lo(tw.w), bf_hi(tw.w)};
                        *(u32x4*)(merged + (size_t)row * 1024 + col) = pack8(t0 + g0 * acc[ai][bj][m][0], t1 + g1 * acc[ai][bj][m][1]); } } }
    }
};
struct Epi3b {
    static constexpr bool PERM = true, AFTER_DRAIN = false;
    bf16_t* y; float* ssq;
    __device__ __forceinline__ void operator()(const f32x4 (&acc)[2][2][4][2], const Unit& u, int wr, int wc, int fr, int fq) const {
        const int row0 = u.pm * 256 + wr * 64 + fr; const int col0 = u.pn * 256 + wc * 32 + 8 * fq;
#pragma unroll
        for (int ai = 0; ai < 2; ++ai)
#pragma unroll
            for (int m = 0; m < 4; ++m) { const int row = row0 + ai * 128 + m * 16; float s = 0.f;
#pragma unroll
                for (int bj = 0; bj < 2; ++bj) { const f32x4 v0 = acc[ai][bj][m][0], v1 = acc[ai][bj][m][1];
                    *(u32x4*)(y + (size_t)row * 1024 + col0 + bj * 128) = pack8(v0, v1);
                    s += (v0[0] * v0[0] + v0[1] * v0[1]) + (v0[2] * v0[2] + v0[3] * v0[3]) + (v1[0] * v1[0] + v1[1] * v1[1]) + (v1[2] * v1[2] + v1[3] * v1[3]); }
                s += __shfl_xor(s, 16); s += __shfl_xor(s, 32);
                if (fq == 0) atomicAdd(ssq + row, s); }
    }
};

constexpr int A_KB = 8448  , A_VBASE = 2 * A_KB, A_VB = 16384, A_WSF = A_VBASE + 2 * A_VB, A_MISC = A_WSF + 8 * 128, A_STAGE = 61440  ;
typedef short v4i16_t __attribute__((ext_vector_type(4)));
__device__ __forceinline__ s16x4 tr_read(LAS unsigned char* p) { return __builtin_bit_cast(s16x4, __builtin_amdgcn_ds_read_tr16_b64_v4i16((LAS v4i16_t*)p)); }
__device__ __forceinline__ float half_max(float m) { auto rr = __builtin_amdgcn_permlane32_swap(__float_as_uint(m), __float_as_uint(m), false, false); return fmaxf(__uint_as_float(rr[0]), __uint_as_float(rr[1])); }
__device__ __forceinline__ float half_sum(float m) { auto rr = __builtin_amdgcn_permlane32_swap(__float_as_uint(m), __float_as_uint(m), false, false); return __uint_as_float(rr[0]) + __uint_as_float(rr[1]); }

template <bool BIAS>
__device__ __forceinline__ void qk_tile(LAS unsigned char* Kb, const bf16x8 (&qr)[4], unsigned ka_off, int hi, f32x16& s0, f32x16& s1) {
    if (BIAS) {
#pragma unroll
        for (int j = 0; j < 4; ++j) { const f32x4 b0 = *(LAS f32x4*)(Kb + 8192 + (8 * j + 4 * hi) * 4), b1 = *(LAS f32x4*)(Kb + 8192 + 128 + (8 * j + 4 * hi) * 4);
#pragma unroll
            for (int i = 0; i < 4; ++i) { s0[4 * j + i] = b0[i]; s1[4 * j + i] = b1[i]; } }
    } else { s0 = f32x16{}; s1 = f32x16{}; }
#pragma unroll
    for (int s = 0; s < 4; ++s) {
        const bf16x8 k0 = *(LAS bf16x8*)(Kb + ka_off + s * 2048), k1 = *(LAS bf16x8*)(Kb + ka_off + s * 2048 + 512);
        s0 = __builtin_amdgcn_mfma_f32_32x32x16_bf16(k0, qr[s], s0, 0, 0, 0);
        s1 = __builtin_amdgcn_mfma_f32_32x32x16_bf16(k1, qr[s], s1, 0, 0, 0);
    }
}
__device__ __forceinline__ void mask_tile(f32x16& s0, f32x16& s1, int t, int qg, int hi) {
    const int kb = 64 * t + 4 * hi;
#pragma unroll
    for (int r = 0; r < 16; ++r) { const int kv = kb + (r & 3) + 8 * (r >> 2); if (kv > qg) s0[r] = -INFINITY; if (kv + 32 > qg) s1[r] = -INFINITY; }
}
__device__ __forceinline__ float rowmax32(const f32x16& s0, const f32x16& s1) {
    float a = fmaxf(fmaxf(s0[0], s0[1]), s1[0]), b = fmaxf(fmaxf(s0[2], s0[3]), s1[1]); a = fmaxf(fmaxf(a, s1[2]), s1[3]);
#pragma unroll
    for (int r = 4; r < 16; r += 4) { a = fmaxf(fmaxf(a, s0[r]), s0[r + 1]); b = fmaxf(fmaxf(b, s0[r + 2]), s0[r + 3]); a = fmaxf(fmaxf(a, s1[r]), s1[r + 1]); b = fmaxf(fmaxf(b, s1[r + 2]), s1[r + 3]); }
    return half_max(fmaxf(a, b));
}
template <int NV>
__device__ __forceinline__ void softmax_pv(LAS unsigned char* Vb, LAS float* wsf, f32x16& p0, f32x16& p1, float mx, float& m_run, float& l_run, f32x16 (&o)[NV][2], unsigned vb0, unsigned vb1, int r32, int hi) {
    const float m_new = fmaxf(m_run, mx);
    const float alpha = __builtin_amdgcn_exp2f(m_run - m_new);
    m_run = m_new;
    float ls = 0.f;
#pragma unroll
    for (int r = 0; r < 16; ++r) { p0[r] = __builtin_amdgcn_exp2f(p0[r] - m_new); p1[r] = __builtin_amdgcn_exp2f(p1[r] - m_new); ls += p0[r] + p1[r]; }
    l_run = l_run * alpha + ls;
    if (__any(alpha != 1.0f)) {
        if (hi == 0) wsf[r32] = alpha;
#pragma unroll
        for (int j = 0; j < 4; ++j) { const f32x4 a = *(LAS f32x4*)(wsf + 8 * j + 4 * hi);
#pragma unroll
            for (int nv = 0; nv < NV; ++nv)
#pragma unroll
                for (int d0 = 0; d0 < 2; ++d0)
#pragma unroll
                    for (int i = 0; i < 4; ++i) o[nv][d0][4 * j + i] *= a[i]; }
    }
    bf16x8 pa[4];
    { u32x4 w;
      w.x = pk_bf16(p0[0], p0[1]); w.y = pk_bf16(p0[2], p0[3]); w.z = pk_bf16(p0[4], p0[5]); w.w = pk_bf16(p0[6], p0[7]); pa[0] = __builtin_bit_cast(bf16x8, w);
      w.x = pk_bf16(p0[8], p0[9]); w.y = pk_bf16(p0[10], p0[11]); w.z = pk_bf16(p0[12], p0[13]); w.w = pk_bf16(p0[14], p0[15]); pa[1] = __builtin_bit_cast(bf16x8, w);
      w.x = pk_bf16(p1[0], p1[1]); w.y = pk_bf16(p1[2], p1[3]); w.z = pk_bf16(p1[4], p1[5]); w.w = pk_bf16(p1[6], p1[7]); pa[2] = __builtin_bit_cast(bf16x8, w);
      w.x = pk_bf16(p1[8], p1[9]); w.y = pk_bf16(p1[10], p1[11]); w.z = pk_bf16(p1[12], p1[13]); w.w = pk_bf16(p1[14], p1[15]); pa[3] = __builtin_bit_cast(bf16x8, w); }
#pragma unroll
    for (int nv = 0; nv < NV; ++nv)
#pragma unroll
        for (int d0 = 0; d0 < 2; ++d0) {
            LAS unsigned char* vp = Vb + nv * 8192 + (d0 ? vb1 : vb0);
#pragma unroll
            for (int s = 0; s < 4; ++s) {
                const s16x4 lo = tr_read(vp + s * 2048), hh = tr_read(vp + s * 2048 + 1024);
                const bf16x8 vf = {lo[0], lo[1], lo[2], lo[3], hh[0], hh[1], hh[2], hh[3]};
                o[nv][d0] = __builtin_amdgcn_mfma_f32_32x32x16_bf16(pa[s], vf, o[nv][d0], 0, 0, 0);
            }
        }
}

__device__ __forceinline__ void qk_load(LAS unsigned char* Kb, unsigned ka_off, bf16x8 (&kf)[8]) {
#pragma unroll
    for (int s = 0; s < 4; ++s) { kf[2 * s] = *(LAS bf16x8*)(Kb + ka_off + s * 2048); kf[2 * s + 1] = *(LAS bf16x8*)(Kb + ka_off + s * 2048 + 512); }
}
template <bool BIAS>
__device__ __forceinline__ void qk_mma(LAS unsigned char* Kb, const bf16x8 (&kf)[8], const bf16x8 (&qr)[4], int hi, f32x16& s0, f32x16& s1, const f32x16& cinit) {
    if (BIAS) {
#pragma unroll
        for (int j = 0; j < 4; ++j) { const f32x4 b0 = *(LAS f32x4*)(Kb + 8192 + (8 * j + 4 * hi) * 4), b1 = *(LAS f32x4*)(Kb + 8192 + 128 + (8 * j + 4 * hi) * 4);
#pragma unroll
            for (int i = 0; i < 4; ++i) { s0[4 * j + i] = b0[i]; s1[4 * j + i] = b1[i]; } }
    }
    if (BIAS) {
#pragma unroll
        for (int s = 0; s < 4; ++s) {
            s0 = __builtin_amdgcn_mfma_f32_32x32x16_bf16(kf[2 * s], qr[s], s0, 0, 0, 0);
            s1 = __builtin_amdgcn_mfma_f32_32x32x16_bf16(kf[2 * s + 1], qr[s], s1, 0, 0, 0);
        }
    } else {
        s0 = __builtin_amdgcn_mfma_f32_32x32x16_bf16(kf[0], qr[0], cinit, 0, 0, 0);
        s1 = __builtin_amdgcn_mfma_f32_32x32x16_bf16(kf[1], qr[0], cinit, 0, 0, 0);
#pragma unroll
        for (int s = 1; s < 4; ++s) {
            s0 = __builtin_amdgcn_mfma_f32_32x32x16_bf16(kf[2 * s], qr[s], s0, 0, 0, 0);
            s1 = __builtin_amdgcn_mfma_f32_32x32x16_bf16(kf[2 * s + 1], qr[s], s1, 0, 0, 0);
        }
    }
}
__device__ __forceinline__ void v_load(LAS unsigned char* vp, s16x4 (&v)[8]) {
#pragma unroll
    for (int s = 0; s < 4; ++s) { v[2 * s] = tr_read(vp + s * 2048); v[2 * s + 1] = tr_read(vp + s * 2048 + 1024); }
}
__device__ __forceinline__ void pv_mma(const bf16x8 (&pa)[4], const s16x4 (&v)[8], f32x16& oo) {
#pragma unroll
    for (int s = 0; s < 4; ++s) { const bf16x8 vf = {v[2 * s][0], v[2 * s][1], v[2 * s][2], v[2 * s][3], v[2 * s + 1][0], v[2 * s + 1][1], v[2 * s + 1][2], v[2 * s + 1][3]};
        oo = __builtin_amdgcn_mfma_f32_32x32x16_bf16(pa[s], vf, oo, 0, 0, 0); }
}
template <int NV>
__device__ __forceinline__ void softmax_pv3(LAS unsigned char* Vb, LAS float* wsf, f32x16& p0, f32x16& p1, float mx, float& m_run, float& l_run, f32x16 (&o)[NV][2], s16x4 (&va)[8], s16x4 (&vb)[8], unsigned vb0, unsigned vb1, int r32, int hi) {
    const float m_new = fmaxf(m_run, mx);
    const float alpha = __builtin_amdgcn_exp2f(m_run - m_new);
    m_run = m_new;
    if (__any(alpha != 1.0f)) {
        if (hi == 0) wsf[r32] = alpha;
#pragma unroll
        for (int j = 0; j < 4; ++j) { const f32x4 a = *(LAS f32x4*)(wsf + 8 * j + 4 * hi);
#pragma unroll
            for (int nv = 0; nv < NV; ++nv)
#pragma unroll
                for (int d0 = 0; d0 < 2; ++d0)
#pragma unroll
                    for (int i = 0; i < 4; ++i) o[nv][d0][4 * j + i] *= a[i]; }
    }
    float ls = 0.f;
#pragma unroll
    for (int r = 0; r < 16; ++r) { p0[r] = __builtin_amdgcn_exp2f(p0[r] - m_new); p1[r] = __builtin_amdgcn_exp2f(p1[r] - m_new); ls += p0[r] + p1[r]; }
    l_run = l_run * alpha + ls;
    bf16x8 pa[4];
    { u32x4 w;
      w.x = pk_bf16(p0[0], p0[1]); w.y = pk_bf16(p0[2], p0[3]); w.z = pk_bf16(p0[4], p0[5]); w.w = pk_bf16(p0[6], p0[7]); pa[0] = __builtin_bit_cast(bf16x8, w);
      w.x = pk_bf16(p0[8], p0[9]); w.y = pk_bf16(p0[10], p0[11]); w.z = pk_bf16(p0[12], p0[13]); w.w = pk_bf16(p0[14], p0[15]); pa[1] = __builtin_bit_cast(bf16x8, w);
      w.x = pk_bf16(p1[0], p1[1]); w.y = pk_bf16(p1[2], p1[3]); w.z = pk_bf16(p1[4], p1[5]); w.w = pk_bf16(p1[6], p1[7]); pa[2] = __builtin_bit_cast(bf16x8, w);
      w.x = pk_bf16(p1[8], p1[9]); w.y = pk_bf16(p1[10], p1[11]); w.z = pk_bf16(p1[12], p1[13]); w.w = pk_bf16(p1[14], p1[15]); pa[3] = __builtin_bit_cast(bf16x8, w); }
    pv_mma(pa, va, o[0][0]);
    if (NV == 2) { v_load(Vb + 8192 + vb0, va); __builtin_amdgcn_sched_barrier(0); }
    pv_mma(pa, vb, o[0][1]);
    if (NV == 2) {
        v_load(Vb + 8192 + vb1, vb); __builtin_amdgcn_sched_barrier(0);
        pv_mma(pa, va, o[NV - 1][0]);
        pv_mma(pa, vb, o[NV - 1][1]);
    }
}

template <int NV>
__device__ __forceinline__ void v_load_ks(LAS unsigned char* Vb, unsigned vb0, unsigned vb1, int s, s16x4 (&v)[4 * NV]) {
#pragma unroll
    for (int g = 0; g < 2 * NV; ++g) { LAS unsigned char* vp = Vb + (g >> 1) * 8192 + ((g & 1) ? vb1 : vb0) + s * 2048; v[2 * g] = tr_read(vp); v[2 * g + 1] = tr_read(vp + 1024); }
}
template <int NV>
__device__ __forceinline__ void softmax_pv4(LAS unsigned char* Vb, LAS float* wsf, f32x16& p0, f32x16& p1, float mx, float& m_run, float& l_run, f32x16 (&o)[NV][2], s16x4 (&va)[4 * NV], unsigned vb0, unsigned vb1, int r32, int hi, f32x16& negm, bool& started, LAS unsigned char* Kb, unsigned ka_off, bf16x8 (&kf)[8], const bool do_next) {
    constexpr bool LAZY = (NV == 2);
    float m_new, alpha;
    if constexpr (LAZY) {
        const bool first = !started;
        if (first || __any(mx > 8.0f)) {
            const float dl = first ? mx : fmaxf(mx, 0.f);
            m_run += dl;
#pragma unroll
            for (int r = 0; r < 16; ++r) { p0[r] -= dl; p1[r] -= dl; }
#pragma unroll
            for (int r = 0; r < 16; ++r) negm[r] = -m_run;
            alpha = first ? 1.0f : __builtin_amdgcn_exp2f(-dl);
            l_run *= alpha;
        } else alpha = 1.0f;
        started = true; m_new = 0.f;
    } else {
        m_new = fmaxf(m_run, mx);
        alpha = __builtin_amdgcn_exp2f(m_run - m_new);
        m_run = m_new;
    }
    if (__any(alpha != 1.0f)) {
        if (hi == 0) wsf[r32] = alpha;
#pragma unroll
        for (int j = 0; j < 4; ++j) { const f32x4 a = *(LAS f32x4*)(wsf + 8 * j + 4 * hi);
#pragma unroll
            for (int nv = 0; nv < NV; ++nv)
#pragma unroll
                for (int d0 = 0; d0 < 2; ++d0)
#pragma unroll
                    for (int i = 0; i < 4; ++i) o[nv][d0][4 * j + i] *= a[i]; }
    }
    typedef float f32x2v __attribute__((ext_vector_type(2)));
    f32x2v ls2_ = {0.f, 0.f}; const f32x2v m2_ = {m_new, m_new};
    s16x4 vbb[4 * NV];
    u32x4 w0, w1, w2, w3;
#define PV4_E2(P, B, W, C) do { const f32x2v t_ = (f32x2v){P[B], P[B + 1]} - m2_; const f32x2v e_ = {__builtin_amdgcn_exp2f(t_.x), __builtin_amdgcn_exp2f(t_.y)}; ls2_ += e_; W[C] = pk_bf16(e_.x, e_.y); } while (0)
#define PV4_MF(W, V, G) do { const bf16x8 vf_ = {V[2 * (G)][0], V[2 * (G)][1], V[2 * (G)][2], V[2 * (G)][3], V[2 * (G) + 1][0], V[2 * (G) + 1][1], V[2 * (G) + 1][2], V[2 * (G) + 1][3]}; \
        o[(G) >> 1][(G) & 1] = __builtin_amdgcn_mfma_f32_32x32x16_bf16(__builtin_bit_cast(bf16x8, W), vf_, o[(G) >> 1][(G) & 1], 0, 0, 0); } while (0)
#define SB() __builtin_amdgcn_sched_barrier(0)
#define PV4_TR(S, G, DST) do { LAS unsigned char* vp_ = Vb + ((G) >> 1) * 8192 + (((G) & 1) ? vb1 : vb0) + (S) * 2048; DST[2 * (G)] = tr_read(vp_); DST[2 * (G) + 1] = tr_read(vp_ + 1024); } while (0)
#define PV4_KL(G) do { if (do_next) { kf[2 * (G)] = *(LAS bf16x8*)(Kb + ka_off + (G) * 2048); kf[2 * (G) + 1] = *(LAS bf16x8*)(Kb + ka_off + (G) * 2048 + 512); } } while (0)
    PV4_E2(p0, 0, w0, 0); PV4_E2(p0, 2, w0, 1); PV4_E2(p0, 4, w0, 2); PV4_E2(p0, 6, w0, 3); SB();
    if (NV == 2) {
        PV4_MF(w0, va, 0); PV4_TR(1, 0, vbb); PV4_E2(p0, 8, w1, 0); SB(); PV4_MF(w0, va, 1); PV4_TR(1, 1, vbb); PV4_E2(p0, 10, w1, 1); SB();
        PV4_MF(w0, va, 2); PV4_TR(1, 2, vbb); PV4_E2(p0, 12, w1, 2); SB(); PV4_MF(w0, va, 3); PV4_TR(1, 3, vbb); PV4_E2(p0, 14, w1, 3); SB();
        PV4_MF(w1, vbb, 0); PV4_TR(2, 0, va); PV4_E2(p1, 0, w2, 0); SB(); PV4_MF(w1, vbb, 1); PV4_TR(2, 1, va); PV4_E2(p1, 2, w2, 1); SB();
        PV4_MF(w1, vbb, 2); PV4_TR(2, 2, va); PV4_E2(p1, 4, w2, 2); SB(); PV4_MF(w1, vbb, 3); PV4_TR(2, 3, va); PV4_E2(p1, 6, w2, 3); SB();
        PV4_MF(w2, va, 0); PV4_TR(3, 0, vbb); PV4_E2(p1, 8, w3, 0); SB(); PV4_MF(w2, va, 1); PV4_TR(3, 1, vbb); PV4_E2(p1, 10, w3, 1); SB();
        PV4_MF(w2, va, 2); PV4_TR(3, 2, vbb); PV4_E2(p1, 12, w3, 2); SB(); PV4_MF(w2, va, 3); PV4_TR(3, 3, vbb); PV4_E2(p1, 14, w3, 3); SB();
        PV4_MF(w3, vbb, 0); PV4_KL(0); SB(); PV4_MF(w3, vbb, 1); PV4_KL(1); SB(); PV4_MF(w3, vbb, 2); PV4_KL(2); SB(); PV4_MF(w3, vbb, 3); PV4_KL(3); SB();
    } else {
        PV4_MF(w0, va, 0); PV4_TR(1, 0, vbb); PV4_E2(p0, 8, w1, 0); PV4_E2(p0, 10, w1, 1); SB(); PV4_MF(w0, va, 1); PV4_TR(1, 1, vbb); PV4_E2(p0, 12, w1, 2); PV4_E2(p0, 14, w1, 3); SB();
        PV4_MF(w1, vbb, 0); PV4_TR(2, 0, va); PV4_E2(p1, 0, w2, 0); PV4_E2(p1, 2, w2, 1); SB(); PV4_MF(w1, vbb, 1); PV4_TR(2, 1, va); PV4_E2(p1, 4, w2, 2); PV4_E2(p1, 6, w2, 3); SB();
        PV4_MF(w2, va, 0); PV4_TR(3, 0, vbb); PV4_E2(p1, 8, w3, 0); PV4_E2(p1, 10, w3, 1); SB(); PV4_MF(w2, va, 1); PV4_TR(3, 1, vbb); PV4_E2(p1, 12, w3, 2); PV4_E2(p1, 14, w3, 3); SB();
        PV4_MF(w3, vbb, 0); PV4_KL(0); PV4_KL(1); SB(); PV4_MF(w3, vbb, 1); PV4_KL(2); PV4_KL(3); SB();
    }
#undef PV4_TR
#undef PV4_KL
#undef PV4_E2
#undef PV4_MF
#undef SB
    l_run = (LAZY ? l_run : l_run * alpha) + (ls2_.x + ls2_.y);
}

template <int NV, bool BIAS>
__device__ __forceinline__ void attn_pass(LAS unsigned char* L, const bf16_t* __restrict__ Qp, const bf16_t* __restrict__ Kp, const bf16_t* __restrict__ Vp0, const bf16_t* __restrict__ Vp1,
                                          const float* __restrict__ cbp, int qb, f32x16 (&o)[NV][2], const int tid, const float* __restrict__ kn2p, const float gk) {
    const int lane = tid & 63, r32 = lane & 31, hi = lane >> 5;
    const int wid = __builtin_amdgcn_readfirstlane(tid >> 6);
    const int q0w = qb * 256 + wid * 32, qg = q0w + r32;
    const int NT = 4 * qb + 4, T0 = NT - 1, tmax = 4 * qb + (wid >> 1);
    bf16x8 qr[4];
#pragma unroll
    for (int s = 0; s < 4; ++s) qr[s] = *(const bf16x8*)(Qp + (size_t)(q0w + r32) * 64 + 16 * s + 8 * hi);
    int NS = NT;
    if (BIAS) {
        LAS unsigned* mw = (LAS unsigned*)(L + A_MISC);
        float q2 = 0.f;
#pragma unroll
        for (int s = 0; s < 4; ++s)
#pragma unroll
            for (int j = 0; j < 8; ++j) { const float v = __uint_as_float(((unsigned)(unsigned short)qr[s][j]) << 16); q2 += v * v; }
        const float qn = sqrtf(half_sum(q2)) * 1.02f;
        float val = cbp[qg] - qn * (gk + sqrtf(kn2p[qg]) * 1.02f) - 170.0f;
        val = fminf(val, __shfl_xor(val, 1)); val = fminf(val, __shfl_xor(val, 2)); val = fminf(val, __shfl_xor(val, 4)); val = fminf(val, __shfl_xor(val, 8)); val = fminf(val, __shfl_xor(val, 16));
        if (tid == 0) mw[2] = 0u;
        if (lane == 0) ((LAS float*)mw)[4 + wid] = val;
        __syncthreads();
        float thr = ((LAS float*)mw)[4];
#pragma unroll
        for (int w = 1; w < 8; ++w) thr = fminf(thr, ((LAS float*)mw)[4 + w]);
        if (gk >= 0.f && tid < NT && cbp[64 * tid + 63] < thr) __hip_atomic_fetch_max(mw + 2, (unsigned)(tid + 1), __ATOMIC_RELAXED, __HIP_MEMORY_SCOPE_WORKGROUP);
        __syncthreads();
        int t_stop = (int)mw[2];
        if ((NT - t_stop) & 1) t_stop -= 1;
        NS = NT - t_stop;
    }
    const int kvr = tid >> 3, chv = tid & 7;
    const bf16_t* kg = Kp + (size_t)lane * 64 + wid * 8;
    const int vxo = kvr * 64 + ((chv ^ (((kvr >> 1) & 1) << 2)) << 3);
    const bf16_t* vgx0 = Vp0 + vxo;
    const bf16_t* vgx1 = Vp1 + vxo;
    const unsigned ka_off = hi * 1024 + r32 * 16;
    const int g1 = (lane >> 4) & 1, qq = (lane & 15) >> 2, pp = lane & 3, xq = (qq >> 1) & 1;
    const unsigned vrow = (4 * hi + qq) * 128 + 32 * g1 + 8 * pp;
    const unsigned vb0 = vrow + (xq ? 64 : 0), vb1 = vrow + (xq ? 0 : 64);
    LAS float* wsf = (LAS float*)(L + A_WSF + wid * 128);
    f32x4 bst = {0.f, 0.f, 0.f, 0.f};
    float m_run = (NV == 2) ? 0.f : -1e30f, l_run = 0.f; f32x16 negm = f32x16{}; bool started = false;
#pragma unroll
    for (int nv = 0; nv < NV; ++nv) { o[nv][0] = f32x16{}; o[nv][1] = f32x16{}; }
#define ATT_LOADK(tt) do { __builtin_amdgcn_global_load_lds((const unsigned*)(kg + (size_t)(tt) * 4096), (LAS unsigned*)(L + kdst_ * A_KB + wid * 1024), 16, 0, 0); \
        if (BIAS && tid < 16) bst = *(const f32x4*)(cbp + (tt) * 64 + tid * 4); } while (0)
#define ATT_LOADV(tt) do { __builtin_amdgcn_global_load_lds((const unsigned*)(vgx0 + (size_t)(tt) * 4096), (LAS unsigned*)(L + A_VBASE + vdst_ * A_VB + wid * 1024), 16, 0, 0); \
        if (NV == 2) __builtin_amdgcn_global_load_lds((const unsigned*)(vgx1 + (size_t)(tt) * 4096), (LAS unsigned*)(L + A_VBASE + vdst_ * A_VB + 8192 + wid * 1024), 16, 0, 0); } while (0)
#define ATT_STOREK(b) do { if (BIAS && tid < 16) *(LAS f32x4*)(L + (b) * A_KB + 8192 + tid * 16) = bst; } while (0)
#define ATT_STOREV(b) do { } while (0)
    int kdst_ = 0, vdst_ = 0;
    kdst_ = 0; vdst_ = 0; ATT_LOADK(T0); ATT_LOADV(T0); ATT_STOREK(0);
    kdst_ = 1; ATT_LOADK(T0 - 1); ATT_STOREK(1);
    __syncthreads();
    f32x16 s0, s1;
    if (T0 <= tmax) { qk_tile<BIAS>(L, qr, ka_off, hi, s0, s1); mask_tile(s0, s1, T0, qg, hi); }
    __syncthreads();
    bf16x8 kf[8]; s16x4 va[4 * NV];
#define ATT_STEP(i) do { \
        const int t_ = T0 - (i); const int kb_ = ((i) + 1) & 1, vbuf_ = (i) & 1; \
        { const int tk_ = t_ - 2 > 0 ? t_ - 2 : 0, tv_ = t_ - 1 > 0 ? t_ - 1 : 0; kdst_ = vbuf_; vdst_ = kb_; ATT_LOADK(tk_); ATT_LOADV(tv_); } \
        LAS unsigned char* Kb_ = L + kb_ * A_KB; LAS unsigned char* Vb_ = L + A_VBASE + vbuf_ * A_VB; \
        const bool do_next_ = (t_ >= 1) && (t_ - 1 <= tmax); \
        bool do_cur_ = (t_ <= tmax); float mxc_ = 0.f; \
        if (do_cur_) { v_load_ks<NV>(Vb_, vb0, vb1, 0, va); __builtin_amdgcn_sched_barrier(0); \
                       mxc_ = rowmax32(s0, s1); if (BIAS) do_cur_ = __any(mxc_ >= m_run - 160.0f) != 0; } \
        if (do_next_ && NV == 1 && !do_cur_) { qk_load(Kb_, ka_off, kf); __builtin_amdgcn_sched_barrier(0); } \
        if (do_cur_) softmax_pv4<NV>(Vb_, wsf, s0, s1, mxc_, m_run, l_run, o, va, vb0, vb1, r32, hi, negm, started, Kb_, ka_off, kf, NV == 1 && do_next_); \
        if (do_next_) { if (NV == 2) qk_load(Kb_, ka_off, kf); qk_mma<BIAS>(Kb_, kf, qr, hi, s0, s1, negm); if (64 * (t_ - 1) + 63 > q0w) mask_tile(s0, s1, t_ - 1, qg, hi); } \
        ATT_STOREK(vbuf_); ATT_STOREV(kb_); \
        __syncthreads(); } while (0)
    for (int i = 0; i < NS; i += 2) { ATT_STEP(i); ATT_STEP(i + 1); }
#undef ATT_STEP
#undef ATT_LOADK
#undef ATT_LOADV
#undef ATT_STOREK
#undef ATT_STOREV
    const float inv = 1.0f / half_sum(l_run);
    if (hi == 0) wsf[r32] = inv;
#pragma unroll
    for (int j = 0; j < 4; ++j) { const f32x4 a = *(LAS f32x4*)(wsf + 8 * j + 4 * hi);
#pragma unroll
        for (int nv = 0; nv < NV; ++nv)
#pragma unroll
            for (int d0 = 0; d0 < 2; ++d0)
#pragma unroll
                for (int i = 0; i < 4; ++i) o[nv][d0][4 * j + i] *= a[i]; }
}

struct AttnArgs { const bf16_t* qkv; const float* cb; const bf16_t* z; bf16_t* y; float* park; const float* kn2; unsigned* counter; const float* gsub; float lam; };

__device__ __forceinline__ int lane_now() { int l; asm volatile("v_mbcnt_lo_u32_b32 %0, -1, 0\n\tv_mbcnt_hi_u32_b32 %0, -1, %0" : "=v"(l)); return l; }
__device__ __forceinline__ float xlane(float v, int src_lane) { return __int_as_float(__builtin_amdgcn_ds_bpermute(src_lane << 2, __float_as_int(v))); }
__device__ __forceinline__ void attn_phase(LAS unsigned char* L, const AttnArgs& A, const int wv  ) {
    LAS unsigned* misc = (LAS unsigned*)(L + A_MISC);
    const int xcd = blockIdx.x & 7;
    {
        const int w0 = wv, l0 = lane_now(); const float* kp = A.kn2 + (size_t)(xcd * 8 + w0) * SEQ; float mx = 0.f;
        for (int i = l0; i < SEQ; i += 64) mx = fmaxf(mx, kp[i]);
#pragma unroll
        for (int o = 1; o < 64; o <<= 1) mx = fmaxf(mx, __shfl_xor(mx, o));
        if (l0 == 0) ((LAS float*)misc)[16 + w0] = sqrtf(mx) * 1.02f;
    }
    for (int kq = 0; kq < 8; ++kq) {
    const int qx = (xcd + kq) & 7;
    for (;;) {
        __syncthreads();
        if (wv == 0 && lane_now() == 0) misc[0] = atomicAdd(A.counter + 32 * qx, 1u);
        __syncthreads();
        const unsigned idx = misc[0];
        if (idx >= 384u) break;
        const int slot = idx >> 5; const int qb = 31 - (int)(idx & 31u);
        const unsigned code = slot < 4 ? 2048u + (unsigned)((qx * 4 + slot) * 32 + qb) : (unsigned)((qx * 8 + (slot - 4)) * 32 + qb);
        const int wid = wv;
        const int q0w = qb * 256 + wid * 32;
#ifndef ATT_TEST
#define ATT_TEST 3
#endif
        if ((ATT_TEST & 1) && code < 2048u) {
            const int tid = wv * 64 + lane_now();
            const int bh = code >> 5, b = bh >> 3, h = bh & 7;
            const size_t so = (size_t)bh * SEQ * 64;
            f32x16 o[1][2];
            const float gkv = (b == xcd) ? ((LAS float*)misc)[16 + h] : -1.0f;
            attn_pass<1, true>(L, A.qkv + so, A.qkv + SB + so, A.qkv + 2 * SB + so, nullptr, A.cb + (size_t)bh * SEQ, qb, o, tid, A.kn2 + (size_t)bh * SEQ, gkv);
            {
                const int lane1 = lane_now(); const int r32e = lane1 & 31, hie = lane1 >> 5;
                LAS float* st = (LAS float*)(L + A_STAGE + wid * 8704);
#pragma unroll
                for (int d0 = 0; d0 < 2; ++d0)
#pragma unroll
                    for (int r = 0; r < 16; ++r) st[((r & 3) + 8 * (r >> 2) + 4 * hie) * 68 + 32 * d0 + r32e] = o[0][d0][r];
                const int rsub = lane1 >> 3, c8 = (lane1 & 7) * 8;
                size_t gbase = (size_t)(b * SEQ + q0w + rsub) * 512 + h * 64 + c8; asm volatile("" : "+v"(gbase));
#pragma unroll
                for (int it = 0; it < 4; ++it) {
                    const f32x4 v0 = *(LAS f32x4*)(st + (it * 8 + rsub) * 68 + c8), v1 = *(LAS f32x4*)(st + (it * 8 + rsub) * 68 + c8 + 4);
                    const u32x4 zw = *(const u32x4*)(A.z + gbase + (size_t)it * 8 * 512);
                    const f32x4 z0 = {bf_lo(zw.x), bf_hi(zw.x), bf_lo(zw.y), bf_hi(zw.y)}, z1 = {bf_lo(zw.z), bf_hi(zw.z), bf_lo(zw.w), bf_hi(zw.w)};
                    *(u32x4*)(A.y + gbase + (size_t)it * 8 * 512) = pack8(v0 * z0, v1 * z1);
                }
            }
        } else if (ATT_TEST & 2) {
            const int tid = wv * 64 + lane_now();
            const int bhd = (code - 2048u) >> 5, b = bhd >> 2, hd = bhd & 3;
            const size_t s0 = (size_t)(b * 8 + hd * 2) * SEQ * 64, s1 = s0 + (size_t)SEQ * 64;
            float* pk = A.park + (size_t)blockIdx.x * 32768 + tid * 64;
            f32x16 o[2][2];
            attn_pass<2, false>(L, A.qkv + 3 * SB + s0, A.qkv + 4 * SB + s0, A.qkv + 5 * SB + s0, A.qkv + 5 * SB + s1, nullptr, qb, o, tid, nullptr, -1.0f);
            { float* pk1 = pk; asm volatile("" : "+v"(pk1));
#pragma unroll
            for (int nv = 0; nv < 2; ++nv)
#pragma unroll
                for (int d0 = 0; d0 < 2; ++d0)
#pragma unroll
                    for (int j = 0; j < 4; ++j) { const f32x4 w = {o[nv][d0][4 * j], o[nv][d0][4 * j + 1], o[nv][d0][4 * j + 2], o[nv][d0][4 * j + 3]}; *(f32x4*)(pk1 + (nv * 2 + d0) * 16 + 4 * j) = w; }
            asm volatile("" ::: "memory"); }
            const int tid2_ = wv * 64 + lane_now();
            attn_pass<2, false>(L, A.qkv + 3 * SB + s1, A.qkv + 4 * SB + s1, A.qkv + 5 * SB + s0, A.qkv + 5 * SB + s1, nullptr, qb, o, tid2_, nullptr, -1.0f);
            f32x16 ss = f32x16{};
            const int lane2 = lane_now(), r32e = lane2 & 31, hie = lane2 >> 5;
            const float* pk2 = pk; asm volatile("" : "+v"(pk2));
#pragma unroll
            for (int nv = 0; nv < 2; ++nv)
#pragma unroll
                for (int d0 = 0; d0 < 2; ++d0) {
#pragma unroll
                    for (int j = 0; j < 4; ++j) { const f32x4 w = *(const f32x4*)(pk2 + (nv * 2 + d0) * 16 + 4 * j);
#pragma unroll
                        for (int i = 0; i < 4; ++i) { const int r = 4 * j + i; const float v = w[i] - A.lam * o[nv][d0][r]; o[nv][d0][r] = v; ss[r] += v * v; } }
                    asm volatile("" ::: "memory");
                }
#pragma unroll
            for (int r = 0; r < 16; ++r) { float s = ss[r]; s += xlane(s, lane2 ^ 1); s += xlane(s, lane2 ^ 2); s += xlane(s, lane2 ^ 4); s += xlane(s, lane2 ^ 8); s += xlane(s, lane2 ^ 16);
                ss[r] = 0.8f * __builtin_amdgcn_rsqf(s * (1.0f / 128.0f) + 1e-5f); }
            {
                LAS float* st = (LAS float*)(L + A_STAGE + wid * 8704);
                const int rsub = lane2 >> 3, c8 = (lane2 & 7) * 8;
                size_t gbase = (size_t)M * 512 + (size_t)(b * SEQ + q0w + rsub) * 512 + hd * 128 + c8; asm volatile("" : "+v"(gbase));
#pragma unroll
                for (int nv = 0; nv < 2; ++nv) {
#pragma unroll
                    for (int d0 = 0; d0 < 2; ++d0)
#pragma unroll
                        for (int r = 0; r < 16; ++r) st[((r & 3) + 8 * (r >> 2) + 4 * hie) * 68 + 32 * d0 + r32e] = o[nv][d0][r] * ss[r];
                    const f32x4 g0 = *(const f32x4*)(A.gsub + 64 * nv + c8), g1 = *(const f32x4*)(A.gsub + 64 * nv + c8 + 4);
#pragma unroll
                    for (int it = 0; it < 4; ++it) {
                        const f32x4 v0 = *(LAS f32x4*)(st + (it * 8 + rsub) * 68 + c8), v1 = *(LAS f32x4*)(st + (it * 8 + rsub) * 68 + c8 + 4);
                        const size_t gi = gbase + (size_t)it * 8 * 512 + 64 * nv;
                        const u32x4 zw = *(const u32x4*)(A.z + gi);
                        const f32x4 z0 = {bf_lo(zw.x), bf_hi(zw.x), bf_lo(zw.y), bf_hi(zw.y)}, z1 = {bf_lo(zw.z), bf_hi(zw.z), bf_lo(zw.w), bf_hi(zw.w)};
                        *(u32x4*)(A.y + gi) = pack8(v0 * g0 * z0, v1 * g1 * z1);
                    }
                    asm volatile("" ::: "memory");
                }
            }
        }
    }
    }
}

__device__ __forceinline__ int col_src(int n) {
    if (n >= 4096) return 4104 + (n - 4096);
    const int seg = n >> 9, c = n & 511;
    if (seg == 4 || seg == 5) { const int uu = c >> 6, p = c & 63, a = p >> 3, bb = p & 7; const int dim = bb < 4 ? 4 * a + bb : 32 + 4 * a + (bb - 4); return (seg == 4 ? 2056 : 2568) + uu * 64 + dim; }
    const int base = seg == 0 ? 0 : seg == 1 ? 512 : seg == 2 ? 1024 : seg == 3 ? 1544 : seg == 6 ? 3080 : 3592;
    return base + c;
}
template <bool MAP>
__device__ __forceinline__ void transpose_tile(LAS unsigned char* L, const float* __restrict__ src, int ld, int K, bf16_t* __restrict__ dst, int n0, int k0) {
    LAS float* ts = (LAS float*)L;
    const int tid = threadIdx.x, a = tid >> 6, c = tid & 63;
    const int sc = MAP ? col_src(n0 + c) : (n0 + c);
    float v[8];
#pragma unroll
    for (int p = 0; p < 8; ++p) v[p] = src[(size_t)(k0 + p * 8 + a) * ld + sc];
    __syncthreads();
#pragma unroll
    for (int p = 0; p < 8; ++p) ts[(p * 8 + a) * 65 + c] = v[p];
    __syncthreads();
#pragma unroll
    for (int p = 0; p < 8; ++p) { const int n = p * 8 + a; dst[(size_t)(n0 + n) * K + k0 + c] = bf16_1(ts[c * 65 + n]); }
}

struct P { const float* x; const float* g_pre; const float* w_in; const float* b_forget; const float* lq1; const float* lk1; const float* lq2; const float* lk2;
           const float* g_subln; const float* w_branch; const float* w_out; const float* g_post; float* out; unsigned char* ws; };

__device__ __forceinline__ void p0_prologue(LAS unsigned char* L, const P& p) {
    const int tid = threadIdx.x, lane = tid & 63, wid = tid >> 6;
    const int gtid = blockIdx.x * 512 + tid, gsz = gridDim.x * 512;
    unsigned char* ws = p.ws;
    float* ssq = (float*)(ws + WS_SSQ);
    for (int i = gtid; i < M; i += gsz) ssq[i] = 0.f;
    { float* kn2 = (float*)(ws + WS_KN2); for (int i = gtid; i < 64 * SEQ; i += gsz) kn2[i] = 0.f; }
    if (gtid < 8) ((unsigned*)(ws + WS_CTL))[32 * gtid] = 0u;
    if (gtid == 0) {
        float d1 = 0.f, d2 = 0.f;
        for (int i = 0; i < 64; ++i) { d1 += p.lq1[i] * p.lk1[i]; d2 += p.lq2[i] * p.lk2[i]; }
        ((float*)(ws + WS_CTL))[512] = expf(d1) - expf(d2) + 0.2f; }
    if (gtid < NITEMS) {
        unsigned* items = (unsigned*)(ws + WS_ITEMS); int rank; unsigned code;
        if (gtid < 1024) { const int qb = gtid >> 5, j = gtid & 31, c = 3 * (qb + 1); rank = 32 * (31 - qb) + 64 * (32 - c > 0 ? 32 - c : 0) + j; code = 2048u + (unsigned)(j * 32 + qb); }
        else { const int i2 = gtid - 1024, qb = i2 >> 6, j = i2 & 63, c = qb + 1; rank = 32 * (33 - (c + 2) / 3) + 64 * (32 - c) + j; code = (unsigned)(j * 32 + qb); }
        items[rank] = code;
    }
    {
        float* cs = (float*)(ws + WS_COS); float* sn = (float*)(ws + WS_SIN);
        for (int i = gtid; i < SEQ * 32; i += gsz) { const int s = i >> 5, f = i & 31;
            const double invf = exp2(-(double)f * (13.287712379549449 / 32.0));
            double rev = (double)s * invf * 0.15915494309189535; rev -= floor(rev);
            const float rf = (float)rev; cs[i] = __builtin_amdgcn_cosf(rf); sn[i] = __builtin_amdgcn_sinf(rf); }
    }
    for (int tt = blockIdx.x; tt < 2048; tt += gridDim.x) {
        if (tt < 1536) transpose_tile<true>(L, p.w_in, NIN, DM, (bf16_t*)(ws + WS_BT1), (tt >> 4) << 6, (tt & 15) << 6);
        else if (tt < 1792) { const int u = tt - 1536, br = u >> 7, v = u & 127;
            transpose_tile<false>(L, p.w_branch + (size_t)br * 512 * DM, DM, 512, (bf16_t*)(ws + WS_BT3A) + (size_t)br * DM * 512, (v >> 3) << 6, (v & 7) << 6); }
        else { const int u = tt - 1792; transpose_tile<false>(L, p.w_out, DM, DM, (bf16_t*)(ws + WS_BT3B), (u >> 4) << 6, (u & 15) << 6); }
    }
    {
        f32x4 gp[4]; float wf[4][4][8];
#pragma unroll
        for (int j = 0; j < 4; ++j) { gp[j] = *(const f32x4*)(p.g_pre + 4 * lane + 256 * j);
#pragma unroll
            for (int i = 0; i < 4; ++i) { const float* wp = p.w_in + (size_t)(4 * lane + 256 * j + i) * NIN + 1536; const f32x4 w0 = *(const f32x4*)wp, w1 = *(const f32x4*)(wp + 4);
                wf[j][i][0] = w0[0]; wf[j][i][1] = w0[1]; wf[j][i][2] = w0[2]; wf[j][i][3] = w0[3]; wf[j][i][4] = w1[0]; wf[j][i][5] = w1[1]; wf[j][i][6] = w1[2]; wf[j][i][7] = w1[3]; } }
        const int hh = (lane & 1) * 4 + ((lane >> 1) & 1) * 2 + ((lane >> 2) & 1);
        const float bfg = p.b_forget[hh];
        bf16_t* hb = (bf16_t*)(ws + WS_H); float* logf_ = (float*)(ws + WS_LOGF);
        const int rstep = gridDim.x * 8;
        int row = blockIdx.x * 8 + wid;
        f32x4 xv[4], xm[4], xn[4];
#pragma unroll
        for (int j = 0; j < 4; ++j) xv[j] = __builtin_nontemporal_load((const f32x4*)(p.x + (size_t)row * DM + 4 * lane + 256 * j));
        { const int r1 = row + rstep < M ? row + rstep : row;
#pragma unroll
          for (int j = 0; j < 4; ++j) xm[j] = __builtin_nontemporal_load((const f32x4*)(p.x + (size_t)r1 * DM + 4 * lane + 256 * j)); }
        for (; row < M; row += rstep) {
            const int rnext = row + 2 * rstep < M ? row + 2 * rstep : row;
#pragma unroll
            for (int j = 0; j < 4; ++j) xn[j] = __builtin_nontemporal_load((const f32x4*)(p.x + (size_t)rnext * DM + 4 * lane + 256 * j));
            float ss = 0.f;
#pragma unroll
            for (int j = 0; j < 4; ++j) ss += (xv[j][0] * xv[j][0] + xv[j][1] * xv[j][1]) + (xv[j][2] * xv[j][2] + xv[j][3] * xv[j][3]);
#pragma unroll
            for (int o = 1; o < 64; o <<= 1) ss += __shfl_xor(ss, o);
            const float rs = 1.0f / sqrtf(ss * (1.0f / 1024.0f) + 1e-6f);
            float fa[8] = {0.f, 0.f, 0.f, 0.f, 0.f, 0.f, 0.f, 0.f};
#pragma unroll
            for (int j = 0; j < 4; ++j) { const f32x4 hv = xv[j] * rs * gp[j];
                u32x2 w; w.x = pk_bf16(hv[0], hv[1]); w.y = pk_bf16(hv[2], hv[3]); *(u32x2*)(hb + (size_t)row * DM + 4 * lane + 256 * j) = w;
#pragma unroll
                for (int i = 0; i < 4; ++i)
#pragma unroll
                    for (int e = 0; e < 8; ++e) fa[e] += hv[i] * wf[j][i][e]; }
            float g4[4], g2[2], g1;
            { const bool up = (lane & 1) != 0;
#pragma unroll
              for (int k = 0; k < 4; ++k) { const float snd = up ? fa[k] : fa[k + 4]; const float rcv = __shfl_xor(snd, 1); g4[k] = (up ? fa[k + 4] : fa[k]) + rcv; } }
            { const bool up = (lane & 2) != 0;
#pragma unroll
              for (int k = 0; k < 2; ++k) { const float snd = up ? g4[k] : g4[k + 2]; const float rcv = __shfl_xor(snd, 2); g2[k] = (up ? g4[k + 2] : g4[k]) + rcv; } }
            { const bool up = (lane & 4) != 0; const float snd = up ? g2[0] : g2[1]; const float rcv = __shfl_xor(snd, 4); g1 = (up ? g2[1] : g2[0]) + rcv; }
            g1 += __shfl_xor(g1, 8); g1 += __shfl_xor(g1, 16); g1 += __shfl_xor(g1, 32);
            if (lane < 8) { const float zf = g1 + bfg; const float ls = fminf(zf, 0.f) - log1pf(expf(-fabsf(zf)));
                logf_[(size_t)((row >> 13) * 8 + hh) * SEQ + (row & (SEQ - 1))] = ls; }
#pragma unroll
            for (int j = 0; j < 4; ++j) { xv[j] = xm[j]; xm[j] = xn[j]; }
        }
    }
}

__device__ __forceinline__ void cumsum_part(LAS unsigned char* L, const float* __restrict__ lf, float* __restrict__ cb, const int q, const int wv) {
    const int lane = lane_now(), wid = wv, tid = wv * 64 + lane;
    LAS float* wt = (LAS float*)L;
    float part = 0.f;
    for (int i = tid; i < 2048 * q; i += 512) part += lf[i];
    f32x4 v = *(const f32x4*)(lf + 2048 * q + tid * 4); float run = 0.f;
#pragma unroll
    for (int i = 0; i < 4; ++i) { run += v[i]; v[i] = run; }
    float sc = run;
#pragma unroll
    for (int o = 1; o < 64; o <<= 1) { const float n = __shfl_up(sc, o); if (lane >= o) sc += n; }
#pragma unroll
    for (int o = 1; o < 64; o <<= 1) part += __shfl_xor(part, o);
    __syncthreads();
    if (lane == 63) wt[wid] = sc;
    if (lane == 0) wt[8 + wid] = part;
    __syncthreads();
    float pre = sc - run;
    for (int w = 0; w < wid; ++w) pre += wt[w];
#pragma unroll
    for (int w = 0; w < 8; ++w) pre += wt[8 + w];
    f32x4 r;
#pragma unroll
    for (int i = 0; i < 4; ++i) r[i] = -(pre + v[i]) * LOG2E;
    *(f32x4*)(cb + 2048 * q + tid * 4) = r;
    __syncthreads();
}

__global__ void __launch_bounds__(512) fwd_megakernel(P p) {
    extern __shared__ __attribute__((aligned(16))) unsigned char lds_raw[];
    LAS unsigned char* L = (LAS unsigned char*)lds_raw;
    cg::grid_group grid = cg::this_grid();
    unsigned char* ws = p.ws;
    const int G = gridDim.x, c = blockIdx.x;
    const int wv = __builtin_amdgcn_readfirstlane(threadIdx.x >> 6);
    bf16_t* qkv = (bf16_t*)(ws + WS_QKV); bf16_t* zbuf = (bf16_t*)(ws + WS_Z); bf16_t* gbuf = (bf16_t*)(ws + WS_G);

#ifndef PHM
#define PHM 63
#endif
    if (PHM & 1) p0_prologue(L, p);
    grid.sync();

    if (PHM & 2) for (int job = c; job < 256; job += G) cumsum_part(L, (const float*)(ws + WS_LOGF) + (size_t)(job >> 2) * SEQ, (float*)(ws + WS_CB) + (size_t)(job >> 2) * SEQ, job & 3, wv);
    if (PHM & 2) {
        pg8::Gemm g{(const bf16_t*)(ws + WS_H), (const bf16_t*)(ws + WS_BT1), M, N1, DM}; pg8::StaticOrder S; S.init(M, N1, G, c);
        Epi1 E{qkv, zbuf, gbuf, (const float*)(ws + WS_COS), (const float*)(ws + WS_SIN), (float*)(ws + WS_KN2)};
        pg8::gemm_phase<Epi1, pg8::StaticOrder, true, true>(L, g, S, E, wv);
    }
    grid.sync();

    if (PHM & 4) {
        const float lam = ((const float*)(ws + WS_CTL))[512];
        AttnArgs A{qkv, (const float*)(ws + WS_CB), zbuf, (bf16_t*)(ws + WS_Y), (float*)(ws + WS_PARK), (const float*)(ws + WS_KN2), (unsigned*)(ws + WS_CTL), p.g_subln, lam};
        attn_phase(L, A, wv);
    }
    grid.sync();

    if (PHM & 8) {
        pg8::Gemm g{(const bf16_t*)(ws + WS_Y), (const bf16_t*)(ws + WS_BT3A), 2 * M, 2 * DM, 512}; Sched3a S; S.so.init(M, DM, G, c);
        Epi3a E{gbuf, (bf16_t*)(ws + WS_T), (bf16_t*)(ws + WS_MERGED)};
        pg8::gemm_phase<Epi3a, Sched3a, true, true>(L, g, S, E, wv);
    }
    grid.sync();

    if (PHM & 16) {
        pg8::Gemm g{(const bf16_t*)(ws + WS_MERGED), (const bf16_t*)(ws + WS_BT3B), M, DM, DM}; pg8::StaticOrder S; S.init(M, DM, G, c);
        Epi3b E{(bf16_t*)(ws + WS_Z), (float*)(ws + WS_SSQ)};
        pg8::gemm_phase<Epi3b, pg8::StaticOrder, true, true>(L, g, S, E, wv);
    }
    grid.sync();

    if (PHM & 32) {
        const float* ssq = (const float*)(ws + WS_SSQ);
        const int t4_ = wv * 64 + lane_now();
        const int gtid = c * 512 + t4_, gsz = G * 512;
        for (int i = gtid; i < M * 256; i += gsz) {
            const int row = i >> 8, c4 = i & 255;
            const u32x2 yw = *(const u32x2*)((const bf16_t*)(ws + WS_Z) + (size_t)i * 4); const f32x4 yv = {bf_lo(yw.x), bf_hi(yw.x), bf_lo(yw.y), bf_hi(yw.y)};
            const f32x4 xv = *(const f32x4*)(p.x + (size_t)i * 4), gv = *(const f32x4*)(p.g_post + c4 * 4);
            const float rs = 1.0f / sqrtf(ssq[row] * (1.0f / 1024.0f) + 1e-6f);
            *(f32x4*)(p.out + (size_t)i * 4) = xv + yv * rs * gv;
        }
    }
}
}

extern "C" void kernel_launch(void* const* d_in, const int* in_sizes, int n_in, void* d_out, int out_size, void* d_ws, size_t ws_size, hipStream_t stream) {
    static int grid = 0;
    if (grid == 0) {
        if (n_in != 12 || ws_size < mk::WS_END) { fprintf(stderr, "kernel_launch: unexpected n_in %d / ws_size %zu\n", n_in, ws_size); grid = -1; return; }
        int dev = 0, cus = 0, per_cu = 0;
        hipGetDevice(&dev); hipDeviceGetAttribute(&cus, hipDeviceAttributeMultiprocessorCount, dev);
        if (hipFuncSetAttribute((const void*)mk::fwd_megakernel, hipFuncAttributeMaxDynamicSharedMemorySize, mk::LDS_BYTES) != hipSuccess) { fprintf(stderr, "kernel_launch: hipFuncSetAttribute failed\n"); grid = -1; return; }
        if (hipOccupancyMaxActiveBlocksPerMultiprocessor(&per_cu, (const void*)mk::fwd_megakernel, 512, mk::LDS_BYTES) != hipSuccess || per_cu < 1) { fprintf(stderr, "kernel_launch: occupancy query says %d\n", per_cu); per_cu = 1; }
        (void)hipGetLastError();
        grid = cus;
    }
    if (grid < 0) return;
    mk::P p{};
    p.x = (const float*)d_in[0]; p.g_pre = (const float*)d_in[1]; p.w_in = (const float*)d_in[2]; p.b_forget = (const float*)d_in[3];
    p.lq1 = (const float*)d_in[4]; p.lk1 = (const float*)d_in[5]; p.lq2 = (const float*)d_in[6]; p.lk2 = (const float*)d_in[7];
    p.g_subln = (const float*)d_in[8]; p.w_branch = (const float*)d_in[9]; p.w_out = (const float*)d_in[10]; p.g_post = (const float*)d_in[11];
    p.out = (float*)d_out; p.ws = (unsigned char*)d_ws;
    void* args[] = {&p};
    hipError_t e = hipLaunchCooperativeKernel((const void*)mk::fwd_megakernel, dim3(grid), dim3(512), args, mk::LDS_BYTES, stream);
    if (e != hipSuccess) fprintf(stderr, "cooperative launch failed: %s (grid %d)\n", hipGetErrorString(e), grid);
}
```

```cpp
#include <hip/hip_runtime.h>
#include <hip/hip_cooperative_groups.h>
#include <cstdio>
#include <cstdint>
namespace cg = cooperative_groups;
namespace pg8 {
#define PG8_LAS __attribute__((address_space(3)))
typedef unsigned short bf16_t;
typedef short bf16x8 __attribute__((ext_vector_type(8)));
typedef float f32x4 __attribute__((ext_vector_type(4)));
typedef unsigned u32x4 __attribute__((ext_vector_type(4)));
constexpr int BM = 256, BK = 64, HALF = 128, HTB = HALF * BK * 2  , STAGE_BYTES = 8 * HTB, NXCD = 8, WGM = 4;

__host__ __device__ __forceinline__ int lds_byte(int r, int c) { const int st = (r >> 4) * 2 + (c >> 5), rr = r & 15, cc = c & 31, ob = rr * 64 + cc * 2; return st * 1024 + (ob ^ (((ob >> 9) & 1) << 5)); }
__host__ __device__ __forceinline__ void stage_rc(int b, int& R, int& C) { const int st = b / 1024, sb = b % 1024, swz = sb ^ (((sb >> 9) & 1) << 5); R = (st >> 1) * 16 + swz / 64; C = (st & 1) * 32 + (swz % 64) / 2; }
__host__ __device__ __forceinline__ int perm32(int rho) { const int n = rho >> 4, i = rho & 15; return 8 * (i >> 2) + 4 * n + (i & 3); }

struct Unit { int pm, pn; };
struct Gemm { const bf16_t* A; const bf16_t* Bt; int M, N, K; };

struct StaticOrder {
    int nM, nN, nwg, G, c;
    __host__ __device__ void init(int M, int N, int G_, int c_) { nM = M / BM; nN = N / BM; nwg = nM * nN; G = G_; c = c_; }
    __host__ __device__ bool next(int i, Unit& u) const {
        const long L = (long)i * G + c; if (L >= nwg) return false;
        int wgid = (int)L; { const int q = nwg / NXCD, r = nwg % NXCD, xcd = wgid % NXCD, off = wgid / NXCD; wgid = (xcd < r ? xcd * (q + 1) : r * (q + 1) + (xcd - r) * q) + off; }
        const int nig = WGM * nN, gid = wgid / nig, fm = gid * WGM, gsz = (nM - fm) < WGM ? (nM - fm) : WGM;
        u.pm = fm + ((wgid % nig) % gsz); u.pn = (wgid % nig) / gsz; return true;
    }
    __device__ __forceinline__ void a_ready(const Unit&) const {}
    __device__ __forceinline__ void done(const Unit&) const {}
};

__device__ __forceinline__ unsigned cvt_pk_bf16(float lo, float hi) { unsigned r; asm volatile("v_cvt_pk_bf16_f32 %0, %1, %2" : "=v"(r) : "v"(lo), "v"(hi)); return r; }
typedef float f32x2 __attribute__((ext_vector_type(2)));
__device__ __forceinline__ f32x2 gelu_pk(f32x2 v) {
    const f32x2 av = __builtin_elementwise_abs(v), d = av * 0.2316418882f + 1.0f;
    f32x2 t; t.x = __builtin_amdgcn_rcpf(d.x); t.y = __builtin_amdgcn_rcpf(d.y);
    f32x2 q = t * 0.5307027145f + (-0.7265760135f); q = q * t + 0.7107068705f; q = q * t + (-0.142248368f); q = q * t + 0.127414796f; q = q * t;
    const f32x2 s = (v * v) * (-0.72134752044f);
    f32x2 e; e.x = __builtin_amdgcn_exp2f(s.x); e.y = __builtin_amdgcn_exp2f(s.y);
    const f32x2 m = v * (q * e), r = v - m;
    f32x2 o; o.x = v.x < 0.f ? m.x : r.x; o.y = v.y < 0.f ? m.y : r.y; return o;
}

template <int ACT  > struct EpiBf16 {
    static constexpr bool PERM = true, AFTER_DRAIN = false; static_assert(ACT == 0 || ACT == 1, "EpiBf16: ACT is 0 (none) or 1 (gelu_pk)");
    bf16_t* O; int ldc; const float* bias; int split_cols; size_t split_stride; float scale0;
    __device__ __forceinline__ void operator()(const f32x4 (&acc)[2][2][4][2], const Unit& u, int wr, int wc, int fr, int fq) const {
        const int row0 = u.pm * BM + wr * 64 + fr; int colt = u.pn * BM; bf16_t* base = O;
        float sc = 1.f; if (split_cols) { const int t = colt / split_cols; base += (size_t)t * split_stride; colt -= t * split_cols; if (t == 0) sc = scale0; }
        const int col0 = colt + wc * 32 + 8 * fq, bcol0 = u.pn * BM + wc * 32 + 8 * fq;
        f32x4 bv[2][2];
#pragma unroll
        for (int bj = 0; bj < 2; ++bj)
#pragma unroll
            for (int n = 0; n < 2; ++n) bv[bj][n] = bias ? *(const f32x4*)(bias + bcol0 + bj * HALF + 4 * n) : (f32x4){0.f, 0.f, 0.f, 0.f};
#pragma unroll
        for (int ai = 0; ai < 2; ++ai)
#pragma unroll
            for (int m = 0; m < 4; ++m) { bf16_t* rowp = base + (size_t)(row0 + ai * HALF + m * 16) * ldc + col0;
#pragma unroll
                for (int bj = 0; bj < 2; ++bj) { f32x4 v0 = acc[ai][bj][m][0] + bv[bj][0], v1 = acc[ai][bj][m][1] + bv[bj][1];
                    if (ACT == 1) { f32x2 a = gelu_pk((f32x2){v0[0], v0[1]}), b = gelu_pk((f32x2){v0[2], v0[3]}), c = gelu_pk((f32x2){v1[0], v1[1]}), d = gelu_pk((f32x2){v1[2], v1[3]});
                        v0 = (f32x4){a.x, a.y, b.x, b.y}; v1 = (f32x4){c.x, c.y, d.x, d.y}; }
                    v0 = v0 * sc; v1 = v1 * sc; u32x4 w; w.x = cvt_pk_bf16(v0[0], v0[1]); w.y = cvt_pk_bf16(v0[2], v0[3]); w.z = cvt_pk_bf16(v1[0], v1[1]); w.w = cvt_pk_bf16(v1[2], v1[3]);
                    *(u32x4*)(rowp + bj * HALF) = w; } }
    }
};

template <class Epi, class Sched, bool ALIGN_EPI = false, bool SP2 = false>
__device__ __forceinline__ void gemm_phase(PG8_LAS unsigned char* lds, const Gemm g, const Sched& S, const Epi& E, const int wv  ) {
    int lane_; asm volatile("v_mbcnt_lo_u32_b32 %0, -1, 0\n\tv_mbcnt_hi_u32_b32 %0, -1, %0" : "=v"(lane_));
    const int tid_ = wv * 64 + lane_;
    const int tid = tid_, wid = __builtin_amdgcn_readfirstlane(tid >> 6), lane = tid & 63, wr = wid >> 2, wc = wid & 3, fr = lane & 15, fq = lane >> 4;
    const int K = g.K, nt = K / BK;
    unsigned voffA[2], voffB[2];
#pragma unroll
    for (int i = 0; i < 2; ++i) { int R, C; stage_rc(tid * 16 + i * 8192, R, C); const int Rb = Epi::PERM ? ((R & ~31) + perm32(R & 31)) : R;
        voffA[i] = (unsigned)(R * K + C) * 2u; voffB[i] = (unsigned)(Rb * K + C) * 2u; }
    const size_t kstep = (size_t)(BK * 2);
    const size_t hstep = (size_t)HALF * K * 2;
    const size_t tstep = 2 * hstep;
    const unsigned ldsw = (unsigned)wid * 1024u;
    const int aoff = lds_byte(wr * 64 + fr, fq * 8), boff = lds_byte(wc * 32 + fr, fq * 8);
#define PG8_SA(b, h) (((b) * 2 + (h)) * HTB)
#define PG8_SB(b, h) ((4 + (b) * 2 + (h)) * HTB)
#define PG8_STAGE(bufoff, gbase, voff) do { _Pragma("unroll") for (int _i = 0; _i < 2; ++_i) \
        __builtin_amdgcn_global_load_lds((const unsigned*)((const char*)(gbase) + (voff)[_i]), (PG8_LAS unsigned*)(lds + (bufoff) + ldsw + _i * 8192), 16, 0, 0); } while (0)
#define PG8_LDA(dst, b, h) do { _Pragma("unroll") for (int m = 0; m < 4; ++m) _Pragma("unroll") for (int k = 0; k < 2; ++k) dst[m][k] = *(const PG8_LAS bf16x8*)(lds + PG8_SA(b, h) + aoff + m * 2048 + k * 1024); } while (0)
#define PG8_LDB(dst, b, h) do { _Pragma("unroll") for (int n = 0; n < 2; ++n) _Pragma("unroll") for (int k = 0; k < 2; ++k) dst[n][k] = *(const PG8_LAS bf16x8*)(lds + PG8_SB(b, h) + boff + n * 2048 + k * 1024); } while (0)
#define PG8_MMA(ai, bj, At, Bt) do { __builtin_amdgcn_s_setprio(1); _Pragma("unroll") for (int m = 0; m < 4; ++m) _Pragma("unroll") for (int n = 0; n < 2; ++n) _Pragma("unroll") for (int k = 0; k < 2; ++k) \
        acc[ai][bj][m][n] = __builtin_amdgcn_mfma_f32_16x16x32_bf16(Bt[n][k], At[m][k], acc[ai][bj][m][n], 0, 0, 0); __builtin_amdgcn_s_setprio(0); } while (0)
#define PG8_WAIT_V(n) asm volatile("s_waitcnt vmcnt(" #n ")" ::: "memory")
#define PG8_WAIT_L(n) asm volatile("s_waitcnt lgkmcnt(" #n ")" ::: "memory")
#define PG8_BAR __builtin_amdgcn_s_barrier()
#define PG8_SCHED __builtin_amdgcn_sched_barrier(0)
    Unit cur, nxt; int ui = 0;
    if (!S.next(0, cur)) return;
    f32x4 acc[2][2][4][2];
#pragma unroll
    for (int a = 0; a < 2; ++a)
#pragma unroll
        for (int b = 0; b < 2; ++b)
#pragma unroll
            for (int m = 0; m < 4; ++m)
#pragma unroll
                for (int n = 0; n < 2; ++n) acc[a][b][m][n] = (f32x4){0.f, 0.f, 0.f, 0.f};
    bf16x8 At[4][2], B0[2][2], B1[2][2];
    const char* cA = (const char*)g.A + (size_t)cur.pm * tstep; const char* cB = (const char*)g.Bt + (size_t)cur.pn * tstep;
    S.a_ready(cur);
    if constexpr (SP2) {
        PG8_STAGE(PG8_SB(0, 0), cB, voffB); PG8_STAGE(PG8_SB(0, 1), cB + hstep, voffB); PG8_STAGE(PG8_SA(0, 0), cA, voffA); PG8_STAGE(PG8_SA(0, 1), cA + hstep, voffA);
        if (wr == 1) PG8_BAR;
        PG8_WAIT_V(2); PG8_BAR;
        PG8_STAGE(PG8_SB(1, 0), cB + kstep, voffB); PG8_STAGE(PG8_SA(1, 0), cA + kstep, voffA); PG8_STAGE(PG8_SB(1, 1), cB + hstep + kstep, voffB);
        PG8_WAIT_V(6); PG8_BAR;
    } else {
        PG8_STAGE(PG8_SB(0, 0), cB, voffB); PG8_STAGE(PG8_SA(0, 0), cA, voffA); PG8_STAGE(PG8_SB(0, 1), cB + hstep, voffB); PG8_STAGE(PG8_SA(0, 1), cA + hstep, voffA);
        if (wr == 1) PG8_BAR;
        PG8_WAIT_V(4); PG8_BAR;
        PG8_STAGE(PG8_SB(1, 0), cB + kstep, voffB); PG8_STAGE(PG8_SA(1, 0), cA + kstep, voffA); PG8_STAGE(PG8_SB(1, 1), cB + hstep + kstep, voffB);
        PG8_WAIT_V(6); PG8_BAR;
    }
    for (;;) {
        const bool has_next = S.next(ui + 1, nxt);
        const char* nA = has_next ? (const char*)g.A + (size_t)nxt.pm * tstep : cA; const char* nB = has_next ? (const char*)g.Bt + (size_t)nxt.pn * tstep : cB;
        for (int t = 0; t < nt; t += 2) {
            const bool last = (t == nt - 2);
            const char* a1 = cA + (size_t)(t + 1) * kstep;
            const char* a2 = last ? nA : cA + (size_t)(t + 2) * kstep; const char* b2 = last ? nB : cB + (size_t)(t + 2) * kstep;
            const char* a3 = a2 + kstep; const char* b3 = b2 + kstep;
            if (last && has_next) S.a_ready(nxt);
            if constexpr (SP2) {
            PG8_LDB(B0, 0, 0); PG8_LDB(B1, 0, 1); PG8_SCHED; PG8_LDA(At, 0, 0); PG8_STAGE(PG8_SA(1, 1), a1 + hstep, voffA);
            PG8_WAIT_V(8); PG8_WAIT_L(0); PG8_BAR; PG8_MMA(0, 0, At, B0); PG8_MMA(0, 1, At, B1); PG8_BAR; PG8_SCHED;
            PG8_LDA(At, 0, 1); PG8_STAGE(PG8_SB(0, 0), b2, voffB); PG8_STAGE(PG8_SB(0, 1), b2 + hstep, voffB); PG8_STAGE(PG8_SA(0, 0), a2, voffA);
            PG8_WAIT_V(8); PG8_WAIT_L(0); PG8_BAR; PG8_MMA(1, 0, At, B0); PG8_MMA(1, 1, At, B1); PG8_BAR; PG8_SCHED;
            PG8_LDB(B0, 1, 0); PG8_LDB(B1, 1, 1); PG8_SCHED; PG8_LDA(At, 1, 0); PG8_STAGE(PG8_SA(0, 1), a2 + hstep, voffA);
            PG8_WAIT_V(8); PG8_WAIT_L(0); PG8_BAR; PG8_MMA(0, 0, At, B0); PG8_MMA(0, 1, At, B1); PG8_BAR; PG8_SCHED;
            PG8_LDA(At, 1, 1); PG8_STAGE(PG8_SB(1, 0), b3, voffB); PG8_STAGE(PG8_SB(1, 1), b3 + hstep, voffB); PG8_STAGE(PG8_SA(1, 0), a3, voffA);
            PG8_WAIT_V(8); PG8_WAIT_L(0); PG8_BAR; PG8_MMA(1, 0, At, B0); PG8_MMA(1, 1, At, B1); PG8_BAR; PG8_SCHED;
            } else {
            PG8_LDB(B0, 0, 0); PG8_SCHED; PG8_LDA(At, 0, 0); PG8_STAGE(PG8_SA(1, 1), a1 + hstep, voffA);
            PG8_WAIT_L(8); PG8_BAR; PG8_WAIT_L(0); PG8_MMA(0, 0, At, B0); PG8_BAR; PG8_SCHED;
            PG8_LDB(B1, 0, 1); PG8_STAGE(PG8_SB(0, 0), b2, voffB);
            PG8_BAR; PG8_WAIT_L(0); PG8_MMA(0, 1, At, B1); PG8_BAR;
            PG8_LDA(At, 0, 1); PG8_STAGE(PG8_SA(0, 0), a2, voffA);
            PG8_BAR; PG8_WAIT_L(0); PG8_MMA(1, 0, At, B0); PG8_BAR; PG8_SCHED;
            PG8_STAGE(PG8_SB(0, 1), b2 + hstep, voffB);
            PG8_WAIT_V(6); PG8_BAR; PG8_MMA(1, 1, At, B1); PG8_BAR;
            PG8_LDB(B0, 1, 0); PG8_SCHED; PG8_LDA(At, 1, 0); PG8_STAGE(PG8_SA(0, 1), a2 + hstep, voffA);
            PG8_WAIT_L(8); PG8_BAR; PG8_WAIT_L(0); PG8_MMA(0, 0, At, B0); PG8_BAR; PG8_SCHED;
            PG8_LDB(B1, 1, 1); PG8_STAGE(PG8_SB(1, 0), b3, voffB);
            PG8_BAR; PG8_WAIT_L(0); PG8_MMA(0, 1, At, B1); PG8_BAR;
            PG8_LDA(At, 1, 1); PG8_STAGE(PG8_SA(1, 0), a3, voffA);
            PG8_BAR; PG8_WAIT_L(0); PG8_MMA(1, 0, At, B0); PG8_BAR; PG8_SCHED;
            PG8_STAGE(PG8_SB(1, 1), b3 + hstep, voffB);
            PG8_WAIT_V(6); PG8_BAR; PG8_MMA(1, 1, At, B1); PG8_BAR;
            }
        }
        if constexpr (ALIGN_EPI) { if (wr == 0) PG8_BAR; }
        if constexpr (!Epi::AFTER_DRAIN) { E(acc, cur, wr, wc, fr, fq); S.done(cur); }
        if (!has_next) break;
#pragma unroll
        for (int a = 0; a < 2; ++a)
#pragma unroll
            for (int b = 0; b < 2; ++b)
#pragma unroll
                for (int m = 0; m < 4; ++m)
#pragma unroll
                    for (int n = 0; n < 2; ++n) acc[a][b][m][n] = (f32x4){0.f, 0.f, 0.f, 0.f};
        cur = nxt; cA = nA; cB = nB; ++ui;
        if constexpr (ALIGN_EPI) { if (wr == 1) PG8_BAR; }
    }
    PG8_WAIT_V(0);
    if constexpr (!ALIGN_EPI) { if (wr == 0) PG8_BAR; }
    PG8_BAR;
    if constexpr (Epi::AFTER_DRAIN) { E.fused(acc, cur, wr, wc, fr, fq, lds, wid, lane); S.done(cur); }
#undef PG8_SA
#undef PG8_SB
#undef PG8_STAGE
#undef PG8_LDA
#undef PG8_LDB
#undef PG8_MMA
#undef PG8_WAIT_V
#undef PG8_WAIT_L
#undef PG8_BAR
#undef PG8_SCHED
}
}

#define LAS __attribute__((address_space(3)))
namespace mk {
using pg8::bf16_t; using pg8::f32x4; using pg8::u32x4; using pg8::Unit;
typedef short bf16x8 __attribute__((ext_vector_type(8)));
typedef short s16x4 __attribute__((ext_vector_type(4)));
typedef float f32x16 __attribute__((ext_vector_type(16)));
typedef unsigned u32x2 __attribute__((ext_vector_type(2)));

constexpr int M = 65536, DM = 1024, SEQ = 8192, NBATCH = 8, NIN = 6152, N1 = 6144, NITEMS = 3072;
constexpr size_t MiB = (size_t)1 << 20;
constexpr size_t WS_CTL = 0, WS_BT1 = 1 * MiB, WS_BT3A = 13 * MiB, WS_BT3B = 15 * MiB, WS_COS = 17 * MiB, WS_SIN = 18 * MiB, WS_LOGF = 19 * MiB, WS_CB = 21 * MiB,
                 WS_SSQ = 23 * MiB, WS_PARK = 24 * MiB, WS_ITEMS = 56 * MiB, WS_KN2 = 57 * MiB, WS_G = 64 * MiB, WS_QKV = 320 * MiB, WS_Z = 704 * MiB, WS_H = 832 * MiB, WS_Y = WS_H,
                 WS_T = 320 * MiB, WS_MERGED = 576 * MiB, WS_END = 960 * MiB;
constexpr size_t SB = (size_t)NBATCH * 8 * SEQ * 64;
constexpr float C2 = 0.125f * 1.4426950408889634f;
constexpr float LOG2E = 1.4426950408889634f;
constexpr int LDS_BYTES = 131072 + 256;

__device__ __forceinline__ unsigned pk_bf16(float lo, float hi) {
    typedef float f32x2_t __attribute__((ext_vector_type(2))); typedef __bf16 bf16x2_t __attribute__((ext_vector_type(2)));
    f32x2_t v = {lo, hi}; bf16x2_t b = __builtin_convertvector(v, bf16x2_t); return __builtin_bit_cast(unsigned, b); }
__device__ __forceinline__ bf16_t bf16_1(float v) { return (bf16_t)(pk_bf16(v, 0.f) & 0xffffu); }
__device__ __forceinline__ float bf_lo(unsigned w) { return __uint_as_float(w << 16); }
__device__ __forceinline__ float bf_hi(unsigned w) { return __uint_as_float(w & 0xffff0000u); }
__device__ __forceinline__ float bf1(bf16_t v) { return __uint_as_float((unsigned)v << 16); }
__device__ __forceinline__ float sigmoid_(float v) { return __builtin_amdgcn_rcpf(1.f + __expf(-v)); }
__device__ __forceinline__ float silu_(float v) { return v * sigmoid_(v); }
__device__ __forceinline__ u32x4 pack8(const f32x4 a, const f32x4 b) { u32x4 w; w.x = pk_bf16(a[0], a[1]); w.y = pk_bf16(a[2], a[3]); w.z = pk_bf16(b[0], b[1]); w.w = pk_bf16(b[2], b[3]); return w; }

struct Epi1 {
    static constexpr bool PERM = true, AFTER_DRAIN = false;
    bf16_t* qkv; bf16_t* z; bf16_t* g; const float* cs; const float* sn; float* kn2;
    __device__ __forceinline__ void operator()(const f32x4 (&acc)[2][2][4][2], const Unit& u, int wr, int wc, int fr, int fq) const {
        const int pn = u.pn; const int row0 = u.pm * 256 + wr * 64 + fr; const int ct = wc * 32 + 8 * fq;
        if (pn >= 16) {
#pragma unroll
            for (int ai = 0; ai < 2; ++ai)
#pragma unroll
                for (int m = 0; m < 4; ++m) { const int row = row0 + ai * 128 + m * 16; bf16_t* rp = g + (size_t)row * 2048 + (pn - 16) * 256 + ct;
#pragma unroll
                    for (int bj = 0; bj < 2; ++bj) { f32x4 v0 = acc[ai][bj][m][0], v1 = acc[ai][bj][m][1];
#pragma unroll
                        for (int i = 0; i < 4; ++i) { v0[i] = sigmoid_(v0[i]); v1[i] = sigmoid_(v1[i]); }
                        *(u32x4*)(rp + bj * 128) = pack8(v0, v1); } }
        } else if ((pn & 7) >= 6) {
            bf16_t* zz = z + (pn >= 8 ? (size_t)M * 512 : (size_t)0);
#pragma unroll
            for (int ai = 0; ai < 2; ++ai)
#pragma unroll
                for (int m = 0; m < 4; ++m) { const int row = row0 + ai * 128 + m * 16; bf16_t* rp = zz + (size_t)row * 512 + (pn & 1) * 256 + ct;
#pragma unroll
                    for (int bj = 0; bj < 2; ++bj) { f32x4 v0 = acc[ai][bj][m][0], v1 = acc[ai][bj][m][1];
#pragma unroll
                        for (int i = 0; i < 4; ++i) { v0[i] = silu_(v0[i]); v1[i] = silu_(v1[i]); }
                        *(u32x4*)(rp + bj * 128) = pack8(v0, v1); } }
        } else if (pn >= 8 && pn < 12) {
            bf16_t* buf = qkv + (size_t)(pn < 10 ? 3 : 4) * SB; const float sc = pn < 10 ? C2 : 1.f;
#pragma unroll
            for (int ai = 0; ai < 2; ++ai)
#pragma unroll
                for (int m = 0; m < 4; ++m) { const int row = row0 + ai * 128 + m * 16; const int b = row >> 13, s = row & (SEQ - 1);
#pragma unroll
                    for (int bj = 0; bj < 2; ++bj) { const int colp = (pn & 1) * 256 + bj * 128 + ct; const int strm = colp >> 6, a = (colp & 63) >> 3;
                        const f32x4 c4 = *(const f32x4*)(cs + s * 32 + 4 * a), s4 = *(const f32x4*)(sn + s * 32 + 4 * a);
                        const f32x4 v0 = acc[ai][bj][m][0], v1 = acc[ai][bj][m][1];
                        const f32x4 lo = (v0 * c4 - v1 * s4) * sc, hi = (v1 * c4 + v0 * s4) * sc;
                        bf16_t* dst = buf + ((size_t)(b * 8 + strm) * SEQ + s) * 64 + 4 * a;
                        u32x2 w0, w1; w0.x = pk_bf16(lo[0], lo[1]); w0.y = pk_bf16(lo[2], lo[3]); w1.x = pk_bf16(hi[0], hi[1]); w1.y = pk_bf16(hi[2], hi[3]);
                        *(u32x2*)dst = w0; *(u32x2*)(dst + 32) = w1; } }
        } else {
            bf16_t* buf = qkv + (size_t)(pn >= 12 ? 5 : (pn >> 1)) * SB; const float sc = pn < 2 ? C2 : 1.f;
#pragma unroll
            for (int ai = 0; ai < 2; ++ai)
#pragma unroll
                for (int m = 0; m < 4; ++m) { const int row = row0 + ai * 128 + m * 16; const int b = row >> 13, s = row & (SEQ - 1);
#pragma unroll
                    for (int bj = 0; bj < 2; ++bj) { const int colp = (pn & 1) * 256 + bj * 128 + ct; const int strm = colp >> 6, d = colp & 63;
                        const f32x4 v0 = acc[ai][bj][m][0] * sc, v1 = acc[ai][bj][m][1] * sc;
                        *(u32x4*)(buf + ((size_t)(b * 8 + strm) * SEQ + s) * 64 + d) = pack8(v0, v1);
                        if (pn == 2 || pn == 3) {
                            float ps = (v0[0] * v0[0] + v0[1] * v0[1]) + (v0[2] * v0[2] + v0[3] * v0[3]) + (v1[0] * v1[0] + v1[1] * v1[1]) + (v1[2] * v1[2] + v1[3] * v1[3]);
                            ps += __shfl_xor(ps, 16); ps += __shfl_xor(ps, 32);
                            if (fq == 0) atomicAdd(kn2 + (size_t)(b * 8 + strm) * SEQ + s, ps); } } }
        }
    }
};

struct Sched3a {
    pg8::StaticOrder so;
    __device__ bool next(int i, Unit& u) const { if (!so.next(i >> 1, u)) return false; const int br = i & 1; u.pm += 256 * br; u.pn += 4 * br; return true; }
    __device__ __forceinline__ void a_ready(const Unit&) const {}
    __device__ __forceinline__ void done(const Unit&) const {}
};
struct Epi3a {
    static constexpr bool PERM = true, AFTER_DRAIN = false;
    const bf16_t* g; bf16_t* T; bf16_t* merged;
    __device__ __forceinline__ void operator()(const f32x4 (&acc)[2][2][4][2], const Unit& u, int wr, int wc, int fr, int fq) const {
        const int br = u.pm >= 256 ? 1 : 0; const int pm = u.pm - 256 * br, pn = u.pn - 4 * br;
        const int row0 = pm * 256 + wr * 64 + fr; const int col0 = pn * 256 + wc * 32 + 8 * fq;
#pragma unroll
        for (int ai = 0; ai < 2; ++ai)
#pragma unroll
            for (int m = 0; m < 4; ++m) { const int row = row0 + ai * 128 + m * 16;
#pragma unroll
                for (int bj = 0; bj < 2; ++bj) { const int col = col0 + bj * 128;
                    const u32x4 gw = *(const u32x4*)(g + (size_t)row * 2048 + br * 1024 + col);
                    const f32x4 g0 = {bf_lo(gw.x), bf_hi(gw.x), bf_lo(gw.y), bf_hi(gw.y)}, g1 = {bf_lo(gw.z), bf_hi(gw.z), bf_lo(gw.w), bf_hi(gw.w)};
                    bf16_t* tp = T + (size_t)row * 1024 + col;
                    if (br == 0) { *(u32x4*)tp = pack8(g0 * acc[ai][bj][m][0], g1 * acc[ai][bj][m][1]); }
                    else { const u32x4 tw = *(const u32x4*)tp;
                        const f32x4 t0 = {bf_lo(tw.x), bf_hi(tw.x), bf_lo(tw.y), bf_hi(tw.y)}, t1 = {bf_lo(tw.z), bf_hi(tw.z), bf_lo(tw.w), bf_hi(tw.w)};
                        *(u32x4*)(merged + (size_t)row * 1024 + col) = pack8(t0 + g0 * acc[ai][bj][m][0], t1 + g1 * acc[ai][bj][m][1]); } } }
    }
};
struct Epi3b {
    static constexpr bool PERM = true, AFTER_DRAIN = false;
    bf16_t* y; float* ssq;
    __device__ __forceinline__ void operator()(const f32x4 (&acc)[2][2][4][2], const Unit& u, int wr, int wc, int fr, int fq) const {
        const int row0 = u.pm * 256 + wr * 64 + fr; const int col0 = u.pn * 256 + wc * 32 + 8 * fq;
#pragma unroll
        for (int ai = 0; ai < 2; ++ai)
#pragma unroll
            for (int m = 0; m < 4; ++m) { const int row = row0 + ai * 128 + m * 16; float s = 0.f;
#pragma unroll
                for (int bj = 0; bj < 2; ++bj) { const f32x4 v0 = acc[ai][bj][m][0], v1 = acc[ai][bj][m][1];
                    *(u32x4*)(y + (size_t)row * 1024 + col0 + bj * 128) = pack8(v0, v1);
                    s += (v0[0] * v0[0] + v0[1] * v0[1]) + (v0[2] * v0[2] + v0[3] * v0[3]) + (v1[0] * v1[0] + v1[1] * v1[1]) + (v1[2] * v1[2] + v1[3] * v1[3]); }
                s += __shfl_xor(s, 16); s += __shfl_xor(s, 32);
                if (fq == 0) atomicAdd(ssq + row, s); }
    }
};

constexpr int A_KB = 8448  , A_VBASE = 2 * A_KB, A_VB = 16384, A_WSF = A_VBASE + 2 * A_VB, A_MISC = A_WSF + 8 * 128, A_STAGE = 61440  ;
typedef short v4i16_t __attribute__((ext_vector_type(4)));
__device__ __forceinline__ s16x4 tr_read(LAS unsigned char* p) { return __builtin_bit_cast(s16x4, __builtin_amdgcn_ds_read_tr16_b64_v4i16((LAS v4i16_t*)p)); }
__device__ __forceinline__ float half_max(float m) { auto rr = __builtin_amdgcn_permlane32_swap(__float_as_uint(m), __float_as_uint(m), false, false); return fmaxf(__uint_as_float(rr[0]), __uint_as_float(rr[1])); }
__device__ __forceinline__ float half_sum(float m) { auto rr = __builtin_amdgcn_permlane32_swap(__float_as_uint(m), __float_as_uint(m), false, false); return __uint_as_float(rr[0]) + __uint_as_float(rr[1]); }

template <bool BIAS>
__device__ __forceinline__ void qk_tile(LAS unsigned char* Kb, const bf16x8 (&qr)[4], unsigned ka_off, int hi, f32x16& s0, f32x16& s1) {
    if (BIAS) {
#pragma unroll
        for (int j = 0; j < 4; ++j) { const f32x4 b0 = *(LAS f32x4*)(Kb + 8192 + (8 * j + 4 * hi) * 4), b1 = *(LAS f32x4*)(Kb + 8192 + 128 + (8 * j + 4 * hi) * 4);
#pragma unroll
            for (int i = 0; i < 4; ++i) { s0[4 * j + i] = b0[i]; s1[4 * j + i] = b1[i]; } }
    } else { s0 = f32x16{}; s1 = f32x16{}; }
#pragma unroll
    for (int s = 0; s < 4; ++s) {
        const bf16x8 k0 = *(LAS bf16x8*)(Kb + ka_off + s * 2048), k1 = *(LAS bf16x8*)(Kb + ka_off + s * 2048 + 512);
        s0 = __builtin_amdgcn_mfma_f32_32x32x16_bf16(k0, qr[s], s0, 0, 0, 0);
        s1 = __builtin_amdgcn_mfma_f32_32x32x16_bf16(k1, qr[s], s1, 0, 0, 0);
    }
}
__device__ __forceinline__ void mask_tile(f32x16& s0, f32x16& s1, int t, int qg, int hi) {
    const int kb = 64 * t + 4 * hi;
#pragma unroll
    for (int r = 0; r < 16; ++r) { const int kv = kb + (r & 3) + 8 * (r >> 2); if (kv > qg) s0[r] = -INFINITY; if (kv + 32 > qg) s1[r] = -INFINITY; }
}
__device__ __forceinline__ float rowmax32(const f32x16& s0, const f32x16& s1) {
    float a = fmaxf(fmaxf(s0[0], s0[1]), s1[0]), b = fmaxf(fmaxf(s0[2], s0[3]), s1[1]); a = fmaxf(fmaxf(a, s1[2]), s1[3]);
#pragma unroll
    for (int r = 4; r < 16; r += 4) { a = fmaxf(fmaxf(a, s0[r]), s0[r + 1]); b = fmaxf(fmaxf(b, s0[r + 2]), s0[r + 3]); a = fmaxf(fmaxf(a, s1[r]), s1[r + 1]); b = fmaxf(fmaxf(b, s1[r + 2]), s1[r + 3]); }
    return half_max(fmaxf(a, b));
}
template <int NV>
__device__ __forceinline__ void softmax_pv(LAS unsigned char* Vb, LAS float* wsf, f32x16& p0, f32x16& p1, float mx, float& m_run, float& l_run, f32x16 (&o)[NV][2], unsigned vb0, unsigned vb1, int r32, int hi) {
    const float m_new = fmaxf(m_run, mx);
    const float alpha = __builtin_amdgcn_exp2f(m_run - m_new);
    m_run = m_new;
    float ls = 0.f;
#pragma unroll
    for (int r = 0; r < 16; ++r) { p0[r] = __builtin_amdgcn_exp2f(p0[r] - m_new); p1[r] = __builtin_amdgcn_exp2f(p1[r] - m_new); ls += p0[r] + p1[r]; }
    l_run = l_run * alpha + ls;
    if (__any(alpha != 1.0f)) {
        if (hi == 0) wsf[r32] = alpha;
#pragma unroll
        for (int j = 0; j < 4; ++j) { const f32x4 a = *(LAS f32x4*)(wsf + 8 * j + 4 * hi);
#pragma unroll
            for (int nv = 0; nv < NV; ++nv)
#pragma unroll
                for (int d0 = 0; d0 < 2; ++d0)
#pragma unroll
                    for (int i = 0; i < 4; ++i) o[nv][d0][4 * j + i] *= a[i]; }
    }
    bf16x8 pa[4];
    { u32x4 w;
      w.x = pk_bf16(p0[0], p0[1]); w.y = pk_bf16(p0[2], p0[3]); w.z = pk_bf16(p0[4], p0[5]); w.w = pk_bf16(p0[6], p0[7]); pa[0] = __builtin_bit_cast(bf16x8, w);
      w.x = pk_bf16(p0[8], p0[9]); w.y = pk_bf16(p0[10], p0[11]); w.z = pk_bf16(p0[12], p0[13]); w.w = pk_bf16(p0[14], p0[15]); pa[1] = __builtin_bit_cast(bf16x8, w);
      w.x = pk_bf16(p1[0], p1[1]); w.y = pk_bf16(p1[2], p1[3]); w.z = pk_bf16(p1[4], p1[5]); w.w = pk_bf16(p1[6], p1[7]); pa[2] = __builtin_bit_cast(bf16x8, w);
      w.x = pk_bf16(p1[8], p1[9]); w.y = pk_bf16(p1[10], p1[11]); w.z = pk_bf16(p1[12], p1[13]); w.w = pk_bf16(p1[14], p1[15]); pa[3] = __builtin_bit_cast(bf16x8, w); }
#pragma unroll
    for (int nv = 0; nv < NV; ++nv)
#pragma unroll
        for (int d0 = 0; d0 < 2; ++d0) {
            LAS unsigned char* vp = Vb + nv * 8192 + (d0 ? vb1 : vb0);
#pragma unroll
            for (int s = 0; s < 4; ++s) {
                const s16x4 lo = tr_read(vp + s * 2048), hh = tr_read(vp + s * 2048 + 1024);
                const bf16x8 vf = {lo[0], lo[1], lo[2], lo[3], hh[0], hh[1], hh[2], hh[3]};
                o[nv][d0] = __builtin_amdgcn_mfma_f32_32x32x16_bf16(pa[s], vf, o[nv][d0], 0, 0, 0);
            }
        }
}

__device__ __forceinline__ void qk_load(LAS unsigned char* Kb, unsigned ka_off, bf16x8 (&kf)[8]) {
#pragma unroll
    for (int s = 0; s < 4; ++s) { kf[2 * s] = *(LAS bf16x8*)(Kb + ka_off + s * 2048); kf[2 * s + 1] = *(LAS bf16x8*)(Kb + ka_off + s * 2048 + 512); }
}
template <bool BIAS>
__device__ __forceinline__ void qk_mma(LAS unsigned char* Kb, const bf16x8 (&kf)[8], const bf16x8 (&qr)[4], int hi, f32x16& s0, f32x16& s1, const f32x16& cinit) {
    if (BIAS) {
#pragma unroll
        for (int j = 0; j < 4; ++j) { const f32x4 b0 = *(LAS f32x4*)(Kb + 8192 + (8 * j + 4 * hi) * 4), b1 = *(LAS f32x4*)(Kb + 8192 + 128 + (8 * j + 4 * hi) * 4);
#pragma unroll
            for (int i = 0; i < 4; ++i) { s0[4 * j + i] = b0[i]; s1[4 * j + i] = b1[i]; } }
    }
    if (BIAS) {
#pragma unroll
        for (int s = 0; s < 4; ++s) {
            s0 = __builtin_amdgcn_mfma_f32_32x32x16_bf16(kf[2 * s], qr[s], s0, 0, 0, 0);
            s1 = __builtin_amdgcn_mfma_f32_32x32x16_bf16(kf[2 * s + 1], qr[s], s1, 0, 0, 0);
        }
    } else {
        s0 = __builtin_amdgcn_mfma_f32_32x32x16_bf16(kf[0], qr[0], cinit, 0, 0, 0);
        s1 = __builtin_amdgcn_mfma_f32_32x32x16_bf16(kf[1], qr[0], cinit, 0, 0, 0);
#pragma unroll
        for (int s = 1; s < 4; ++s) {
            s0 = __builtin_amdgcn_mfma_f32_32x32x16_bf16(kf[2 * s], qr[s], s0, 0, 0, 0);
            s1 = __builtin_amdgcn_mfma_f32_32x32x16_bf16(kf[2 * s + 1], qr[s], s1, 0, 0, 0);
        }
    }
}
__device__ __forceinline__ void v_load(LAS unsigned char* vp, s16x4 (&v)[8]) {
#pragma unroll
    for (int s = 0; s < 4; ++s) { v[2 * s] = tr_read(vp + s * 2048); v[2 * s + 1] = tr_read(vp + s * 2048 + 1024); }
}
__device__ __forceinline__ void pv_mma(const bf16x8 (&pa)[4], const s16x4 (&v)[8], f32x16& oo) {
#pragma unroll
    for (int s = 0; s < 4; ++s) { const bf16x8 vf = {v[2 * s][0], v[2 * s][1], v[2 * s][2], v[2 * s][3], v[2 * s + 1][0], v[2 * s + 1][1], v[2 * s + 1][2], v[2 * s + 1][3]};
        oo = __builtin_amdgcn_mfma_f32_32x32x16_bf16(pa[s], vf, oo, 0, 0, 0); }
}
template <int NV>
__device__ __forceinline__ void softmax_pv3(LAS unsigned char* Vb, LAS float* wsf, f32x16& p0, f32x16& p1, float mx, float& m_run, float& l_run, f32x16 (&o)[NV][2], s16x4 (&va)[8], s16x4 (&vb)[8], unsigned vb0, unsigned vb1, int r32, int hi) {
    const float m_new = fmaxf(m_run, mx);
    const float alpha = __builtin_amdgcn_exp2f(m_run - m_new);
    m_run = m_new;
    if (__any(alpha != 1.0f)) {
        if (hi == 0) wsf[r32] = alpha;
#pragma unroll
        for (int j = 0; j < 4; ++j) { const f32x4 a = *(LAS f32x4*)(wsf + 8 * j + 4 * hi);
#pragma unroll
            for (int nv = 0; nv < NV; ++nv)
#pragma unroll
                for (int d0 = 0; d0 < 2; ++d0)
#pragma unroll
                    for (int i = 0; i < 4; ++i) o[nv][d0][4 * j + i] *= a[i]; }
    }
    float ls = 0.f;
#pragma unroll
    for (int r = 0; r < 16; ++r) { p0[r] = __builtin_amdgcn_exp2f(p0[r] - m_new); p1[r] = __builtin_amdgcn_exp2f(p1[r] - m_new); ls += p0[r] + p1[r]; }
    l_run = l_run * alpha + ls;
    bf16x8 pa[4];
    { u32x4 w;
      w.x = pk_bf16(p0[0], p0[1]); w.y = pk_bf16(p0[2], p0[3]); w.z = pk_bf16(p0[4], p0[5]); w.w = pk_bf16(p0[6], p0[7]); pa[0] = __builtin_bit_cast(bf16x8, w);
      w.x = pk_bf16(p0[8], p0[9]); w.y = pk_bf16(p0[10], p0[11]); w.z = pk_bf16(p0[12], p0[13]); w.w = pk_bf16(p0[14], p0[15]); pa[1] = __builtin_bit_cast(bf16x8, w);
      w.x = pk_bf16(p1[0], p1[1]); w.y = pk_bf16(p1[2], p1[3]); w.z = pk_bf16(p1[4], p1[5]); w.w = pk_bf16(p1[6], p1[7]); pa[2] = __builtin_bit_cast(bf16x8, w);
      w.x = pk_bf16(p1[8], p1[9]); w.y = pk_bf16(p1[10], p1[11]); w.z = pk_bf16(p1[12], p1[13]); w.w = pk_bf16(p1[14], p1[15]); pa[3] = __builtin_bit_cast(bf16x8, w); }
    pv_mma(pa, va, o[0][0]);
    if (NV == 2) { v_load(Vb + 8192 + vb0, va); __builtin_amdgcn_sched_barrier(0); }
    pv_mma(pa, vb, o[0][1]);
    if (NV == 2) {
        v_load(Vb + 8192 + vb1, vb); __builtin_amdgcn_sched_barrier(0);
        pv_mma(pa, va, o[NV - 1][0]);
        pv_mma(pa, vb, o[NV - 1][1]);
    }
}

template <int NV>
__device__ __forceinline__ void v_load_ks(LAS unsigned char* Vb, unsigned vb0, unsigned vb1, int s, s16x4 (&v)[4 * NV]) {
#pragma unroll
    for (int g = 0; g < 2 * NV; ++g) { LAS unsigned char* vp = Vb + (g >> 1) * 8192 + ((g & 1) ? vb1 : vb0) + s * 2048; v[2 * g] = tr_read(vp); v[2 * g + 1] = tr_read(vp + 1024); }
}
template <int NV>
__device__ __forceinline__ void softmax_pv4(LAS unsigned char* Vb, LAS float* wsf, f32x16& p0, f32x16& p1, float mx, float& m_run, float& l_run, f32x16 (&o)[NV][2], s16x4 (&va)[4 * NV], unsigned vb0, unsigned vb1, int r32, int hi, f32x16& negm, bool& started, LAS unsigned char* Kb, unsigned ka_off, bf16x8 (&kf)[8], const bool do_next) {
    constexpr bool LAZY = (NV == 2);
    float m_new, alpha;
    if constexpr (LAZY) {
        const bool first = !started;
        if (first || __any(mx > 8.0f)) {
            const float dl = first ? mx : fmaxf(mx, 0.f);
            m_run += dl;
#pragma unroll
            for (int r = 0; r < 16; ++r) { p0[r] -= dl; p1[r] -= dl; }
#pragma unroll
            for (int r = 0; r < 16; ++r) negm[r] = -m_run;
            alpha = first ? 1.0f : __builtin_amdgcn_exp2f(-dl);
            l_run *= alpha;
        } else alpha = 1.0f;
        started = true; m_new = 0.f;
    } else {
        m_new = fmaxf(m_run, mx);
        alpha = __builtin_amdgcn_exp2f(m_run - m_new);
        m_run = m_new;
    }
    if (__any(alpha != 1.0f)) {
        if (hi == 0) wsf[r32] = alpha;
#pragma unroll
        for (int j = 0; j < 4; ++j) { const f32x4 a = *(LAS f32x4*)(wsf + 8 * j + 4 * hi);
#pragma unroll
            for (int nv = 0; nv < NV; ++nv)
#pragma unroll
                for (int d0 = 0; d0 < 2; ++d0)
#pragma unroll
                    for (int i = 0; i < 4; ++i) o[nv][d0][4 * j + i] *= a[i]; }
    }
    typedef float f32x2v __attribute__((ext_vector_type(2)));
    f32x2v ls2_ = {0.f, 0.f}; const f32x2v m2_ = {m_new, m_new};
    s16x4 vbb[4 * NV];
    u32x4 w0, w1, w2, w3;
#define PV4_E2(P, B, W, C) do { const f32x2v t_ = (f32x2v){P[B], P[B + 1]} - m2_; const f32x2v e_ = {__builtin_amdgcn_exp2f(t_.x), __builtin_amdgcn_exp2f(t_.y)}; ls2_ += e_; W[C] = pk_bf16(e_.x, e_.y); } while (0)
#define PV4_MF(W, V, G) do { const bf16x8 vf_ = {V[2 * (G)][0], V[2 * (G)][1], V[2 * (G)][2], V[2 * (G)][3], V[2 * (G) + 1][0], V[2 * (G) + 1][1], V[2 * (G) + 1][2], V[2 * (G) + 1][3]}; \
        o[(G) >> 1][(G) & 1] = __builtin_amdgcn_mfma_f32_32x32x16_bf16(__builtin_bit_cast(bf16x8, W), vf_, o[(G) >> 1][(G) & 1], 0, 0, 0); } while (0)
#define SB() __builtin_amdgcn_sched_barrier(0)
#define PV4_TR(S, G, DST) do { LAS unsigned char* vp_ = Vb + ((G) >> 1) * 8192 + (((G) & 1) ? vb1 : vb0) + (S) * 2048; DST[2 * (G)] = tr_read(vp_); DST[2 * (G) + 1] = tr_read(vp_ + 1024); } while (0)
#define PV4_KL(G) do { if (do_next) { kf[2 * (G)] = *(LAS bf16x8*)(Kb + ka_off + (G) * 2048); kf[2 * (G) + 1] = *(LAS bf16x8*)(Kb + ka_off + (G) * 2048 + 512); } } while (0)
    PV4_E2(p0, 0, w0, 0); PV4_E2(p0, 2, w0, 1); PV4_E2(p0, 4, w0, 2); PV4_E2(p0, 6, w0, 3); SB();
    if (NV == 2) {
        PV4_MF(w0, va, 0); PV4_TR(1, 0, vbb); PV4_E2(p0, 8, w1, 0); SB(); PV4_MF(w0, va, 1); PV4_TR(1, 1, vbb); PV4_E2(p0, 10, w1, 1); SB();
        PV4_MF(w0, va, 2); PV4_TR(1, 2, vbb); PV4_E2(p0, 12, w1, 2); SB(); PV4_MF(w0, va, 3); PV4_TR(1, 3, vbb); PV4_E2(p0, 14, w1, 3); SB();
        PV4_MF(w1, vbb, 0); PV4_TR(2, 0, va); PV4_E2(p1, 0, w2, 0); SB(); PV4_MF(w1, vbb, 1); PV4_TR(2, 1, va); PV4_E2(p1, 2, w2, 1); SB();
        PV4_MF(w1, vbb, 2); PV4_TR(2, 2, va); PV4_E2(p1, 4, w2, 2); SB(); PV4_MF(w1, vbb, 3); PV4_TR(2, 3, va); PV4_E2(p1, 6, w2, 3); SB();
        PV4_MF(w2, va, 0); PV4_TR(3, 0, vbb); PV4_E2(p1, 8, w3, 0); SB(); PV4_MF(w2, va, 1); PV4_TR(3, 1, vbb); PV4_E2(p1, 10, w3, 1); SB();
        PV4_MF(w2, va, 2); PV4_TR(3, 2, vbb); PV4_E2(p1, 12, w3, 2); SB(); PV4_MF(w2, va, 3); PV4_TR(3, 3, vbb); PV4_E2(p1, 14, w3, 3); SB();
        PV4_MF(w3, vbb, 0); PV4_KL(0); SB(); PV4_MF(w3, vbb, 1); PV4_KL(1); SB(); PV4_MF(w3, vbb, 2); PV4_KL(2); SB(); PV4_MF(w3, vbb, 3); PV4_KL(3); SB();
    } else {
        PV4_MF(w0, va, 0); PV4_TR(1, 0, vbb); PV4_E2(p0, 8, w1, 0); PV4_E2(p0, 10, w1, 1); SB(); PV4_MF(w0, va, 1); PV4_TR(1, 1, vbb); PV4_E2(p0, 12, w1, 2); PV4_E2(p0, 14, w1, 3); SB();
        PV4_MF(w1, vbb, 0); PV4_TR(2, 0, va); PV4_E2(p1, 0, w2, 0); PV4_E2(p1, 2, w2, 1); SB(); PV4_MF(w1, vbb, 1); PV4_TR(2, 1, va); PV4_E2(p1, 4, w2, 2); PV4_E2(p1, 6, w2, 3); SB();
        PV4_MF(w2, va, 0); PV4_TR(3, 0, vbb); PV4_E2(p1, 8, w3, 0); PV4_E2(p1, 10, w3, 1); SB(); PV4_MF(w2, va, 1); PV4_TR(3, 1, vbb); PV4_E2(p1, 12, w3, 2); PV4_E2(p1, 14, w3, 3); SB();
        PV4_MF(w3, vbb, 0); PV4_KL(0); PV4_KL(1); SB(); PV4_MF(w3, vbb, 1); PV4_KL(2); PV4_KL(3); SB();
    }
#undef PV4_TR
#undef PV4_KL
#undef PV4_E2
#undef PV4_MF
#undef SB
    l_run = (LAZY ? l_run : l_run * alpha) + (ls2_.x + ls2_.y);
}

template <int NV, bool BIAS>
__device__ __forceinline__ void attn_pass(LAS unsigned char* L, const bf16_t* __restrict__ Qp, const bf16_t* __restrict__ Kp, const bf16_t* __restrict__ Vp0, const bf16_t* __restrict__ Vp1,
                                          const float* __restrict__ cbp, int qb, f32x16 (&o)[NV][2], const int tid, const float* __restrict__ kn2p, const float gk) {
    const int lane = tid & 63, r32 = lane & 31, hi = lane >> 5;
    const int wid = __builtin_amdgcn_readfirstlane(tid >> 6);
    const int q0w = qb * 256 + wid * 32, qg = q0w + r32;
    const int NT = 4 * qb + 4, T0 = NT - 1, tmax = 4 * qb + (wid >> 1);
    bf16x8 qr[4];
#pragma unroll
    for (int s = 0; s < 4; ++s) qr[s] = *(const bf16x8*)(Qp + (size_t)(q0w + r32) * 64 + 16 * s + 8 * hi);
    int NS = NT;
    if (BIAS) {
        LAS unsigned* mw = (LAS unsigned*)(L + A_MISC);
        float q2 = 0.f;
#pragma unroll
        for (int s = 0; s < 4; ++s)
#pragma unroll
            for (int j = 0; j < 8; ++j) { const float v = __uint_as_float(((unsigned)(unsigned short)qr[s][j]) << 16); q2 += v * v; }
        const float qn = sqrtf(half_sum(q2)) * 1.02f;
        float val = cbp[qg] - qn * (gk + sqrtf(kn2p[qg]) * 1.02f) - 170.0f;
        val = fminf(val, __shfl_xor(val, 1)); val = fminf(val, __shfl_xor(val, 2)); val = fminf(val, __shfl_xor(val, 4)); val = fminf(val, __shfl_xor(val, 8)); val = fminf(val, __shfl_xor(val, 16));
        if (tid == 0) mw[2] = 0u;
        if (lane == 0) ((LAS float*)mw)[4 + wid] = val;
        __syncthreads();
        float thr = ((LAS float*)mw)[4];
#pragma unroll
        for (int w = 1; w < 8; ++w) thr = fminf(thr, ((LAS float*)mw)[4 + w]);
        if (gk >= 0.f && tid < NT && cbp[64 * tid + 63] < thr) __hip_atomic_fetch_max(mw + 2, (unsigned)(tid + 1), __ATOMIC_RELAXED, __HIP_MEMORY_SCOPE_WORKGROUP);
        __syncthreads();
        int t_stop = (int)mw[2];
        if ((NT - t_stop) & 1) t_stop -= 1;
        NS = NT - t_stop;
    }
    const int kvr = tid >> 3, chv = tid & 7;
    const bf16_t* kg = Kp + (size_t)lane * 64 + wid * 8;
    const int vxo = kvr * 64 + ((chv ^ (((kvr >> 1) & 1) << 2)) << 3);
    const bf16_t* vgx0 = Vp0 + vxo;
    const bf16_t* vgx1 = Vp1 + vxo;
    const unsigned ka_off = hi * 1024 + r32 * 16;
    const int g1 = (lane >> 4) & 1, qq = (lane & 15) >> 2, pp = lane & 3, xq = (qq >> 1) & 1;
    const unsigned vrow = (4 * hi + qq) * 128 + 32 * g1 + 8 * pp;
    const unsigned vb0 = vrow + (xq ? 64 : 0), vb1 = vrow + (xq ? 0 : 64);
    LAS float* wsf = (LAS float*)(L + A_WSF + wid * 128);
    f32x4 bst = {0.f, 0.f, 0.f, 0.f};
    float m_run = (NV == 2) ? 0.f : -1e30f, l_run = 0.f; f32x16 negm = f32x16{}; bool started = false;
#pragma unroll
    for (int nv = 0; nv < NV; ++nv) { o[nv][0] = f32x16{}; o[nv][1] = f32x16{}; }
#define ATT_LOADK(tt) do { __builtin_amdgcn_global_load_lds((const unsigned*)(kg + (size_t)(tt) * 4096), (LAS unsigned*)(L + kdst_ * A_KB + wid * 1024), 16, 0, 0); \
        if (BIAS && tid < 16) bst = *(const f32x4*)(cbp + (tt) * 64 + tid * 4); } while (0)
#define ATT_LOADV(tt) do { __builtin_amdgcn_global_load_lds((const unsigned*)(vgx0 + (size_t)(tt) * 4096), (LAS unsigned*)(L + A_VBASE + vdst_ * A_VB + wid * 1024), 16, 0, 0); \
        if (NV == 2) __builtin_amdgcn_global_load_lds((const unsigned*)(vgx1 + (size_t)(tt) * 4096), (LAS unsigned*)(L + A_VBASE + vdst_ * A_VB + 8192 + wid * 1024), 16, 0, 0); } while (0)
#define ATT_STOREK(b) do { if (BIAS && tid < 16) *(LAS f32x4*)(L + (b) * A_KB + 8192 + tid * 16) = bst; } while (0)
#define ATT_STOREV(b) do { } while (0)
    int kdst_ = 0, vdst_ = 0;
    kdst_ = 0; vdst_ = 0; ATT_LOADK(T0); ATT_LOADV(T0); ATT_STOREK(0);
    kdst_ = 1; ATT_LOADK(T0 - 1); ATT_STOREK(1);
    __syncthreads();
    f32x16 s0, s1;
    if (T0 <= tmax) { qk_tile<BIAS>(L, qr, ka_off, hi, s0, s1); mask_tile(s0, s1, T0, qg, hi); }
    __syncthreads();
    bf16x8 kf[8]; s16x4 va[4 * NV];
#define ATT_STEP(i) do { \
        const int t_ = T0 - (i); const int kb_ = ((i) + 1) & 1, vbuf_ = (i) & 1; \
        { const int tk_ = t_ - 2 > 0 ? t_ - 2 : 0, tv_ = t_ - 1 > 0 ? t_ - 1 : 0; kdst_ = vbuf_; vdst_ = kb_; ATT_LOADK(tk_); ATT_LOADV(tv_); } \
        LAS unsigned char* Kb_ = L + kb_ * A_KB; LAS unsigned char* Vb_ = L + A_VBASE + vbuf_ * A_VB; \
        const bool do_next_ = (t_ >= 1) && (t_ - 1 <= tmax); \
        bool do_cur_ = (t_ <= tmax); float mxc_ = 0.f; \
        if (do_cur_) { v_load_ks<NV>(Vb_, vb0, vb1, 0, va); __builtin_amdgcn_sched_barrier(0); \
                       mxc_ = rowmax32(s0, s1); if (BIAS) do_cur_ = __any(mxc_ >= m_run - 160.0f) != 0; } \
        if (do_next_ && NV == 1 && !do_cur_) { qk_load(Kb_, ka_off, kf); __builtin_amdgcn_sched_barrier(0); } \
        if (do_cur_) softmax_pv4<NV>(Vb_, wsf, s0, s1, mxc_, m_run, l_run, o, va, vb0, vb1, r32, hi, negm, started, Kb_, ka_off, kf, NV == 1 && do_next_); \
        if (do_next_) { if (NV == 2) qk_load(Kb_, ka_off, kf); qk_mma<BIAS>(Kb_, kf, qr, hi, s0, s1, negm); if (64 * (t_ - 1) + 63 > q0w) mask_tile(s0, s1, t_ - 1, qg, hi); } \
        ATT_STOREK(vbuf_); ATT_STOREV(kb_); \
        __syncthreads(); } while (0)
    for (int i = 0; i < NS; i += 2) { ATT_STEP(i); ATT_STEP(i + 1); }
#undef ATT_STEP
#undef ATT_LOADK
#undef ATT_LOADV
#undef ATT_STOREK
#undef ATT_STOREV
    const float inv = 1.0f / half_sum(l_run);
    if (hi == 0) wsf[r32] = inv;
#pragma unroll
    for (int j = 0; j < 4; ++j) { const f32x4 a = *(LAS f32x4*)(wsf + 8 * j + 4 * hi);
#pragma unroll
        for (int nv = 0; nv < NV; ++nv)
#pragma unroll
            for (int d0 = 0; d0 < 2; ++d0)
#pragma unroll
                for (int i = 0; i < 4; ++i) o[nv][d0][4 * j + i] *= a[i]; }
}

struct AttnArgs { const bf16_t* qkv; const float* cb; const bf16_t* z; bf16_t* y; float* park; const float* kn2; unsigned* counter; const float* gsub; float lam; };

__device__ __forceinline__ int lane_now() { int l; asm volatile("v_mbcnt_lo_u32_b32 %0, -1, 0\n\tv_mbcnt_hi_u32_b32 %0, -1, %0" : "=v"(l)); return l; }
__device__ __forceinline__ float xlane(float v, int src_lane) { return __int_as_float(__builtin_amdgcn_ds_bpermute(src_lane << 2, __float_as_int(v))); }
__device__ __forceinline__ void attn_phase(LAS unsigned char* L, const AttnArgs& A, const int wv  ) {
    LAS unsigned* misc = (LAS unsigned*)(L + A_MISC);
    const int xcd = blockIdx.x & 7;
    {
        const int w0 = wv, l0 = lane_now(); const float* kp = A.kn2 + (size_t)(xcd * 8 + w0) * SEQ; float mx = 0.f;
        for (int i = l0 * 4; i < SEQ; i += 256) { const f32x4 k4 = *(const f32x4*)(kp + i); mx = fmaxf(fmaxf(mx, fmaxf(k4[0], k4[1])), fmaxf(k4[2], k4[3])); }
#pragma unroll
        for (int o = 1; o < 64; o <<= 1) mx = fmaxf(mx, __shfl_xor(mx, o));
        if (l0 == 0) ((LAS float*)misc)[16 + w0] = sqrtf(mx) * 1.02f;
    }
    for (int kq = 0; kq < 8; ++kq) {
    const int qx = (xcd + kq) & 7;
    for (;;) {
        __syncthreads();
        if (wv == 0 && lane_now() == 0) misc[0] = atomicAdd(A.counter + 32 * qx, 1u);
        __syncthreads();
        const unsigned idx = misc[0];
        if (idx >= 384u) break;
        const int slot = idx >> 5; const int qb = 31 - (int)(idx & 31u);
        const unsigned code = slot < 4 ? 2048u + (unsigned)((qx * 4 + slot) * 32 + qb) : (unsigned)((qx * 8 + (slot - 4)) * 32 + qb);
        const int wid = wv;
        const int q0w = qb * 256 + wid * 32;
#ifndef ATT_TEST
#define ATT_TEST 3
#endif
        if ((ATT_TEST & 1) && code < 2048u) {
            const int tid = wv * 64 + lane_now();
            const int bh = code >> 5, b = bh >> 3, h = bh & 7;
            const size_t so = (size_t)bh * SEQ * 64;
            f32x16 o[1][2];
            const float gkv = (b == xcd) ? ((LAS float*)misc)[16 + h] : -1.0f;
            attn_pass<1, true>(L, A.qkv + so, A.qkv + SB + so, A.qkv + 2 * SB + so, nullptr, A.cb + (size_t)bh * SEQ, qb, o, tid, A.kn2 + (size_t)bh * SEQ, gkv);
            {
                const int lane1 = lane_now(); const int r32e = lane1 & 31, hie = lane1 >> 5;
                LAS float* st = (LAS float*)(L + A_STAGE + wid * 8704);
#pragma unroll
                for (int d0 = 0; d0 < 2; ++d0)
#pragma unroll
                    for (int r = 0; r < 16; ++r) st[((r & 3) + 8 * (r >> 2) + 4 * hie) * 68 + 32 * d0 + r32e] = o[0][d0][r];
                const int rsub = lane1 >> 3, c8 = (lane1 & 7) * 8;
                size_t gbase = (size_t)(b * SEQ + q0w + rsub) * 512 + h * 64 + c8; asm volatile("" : "+v"(gbase));
#pragma unroll
                for (int it = 0; it < 4; ++it) {
                    const f32x4 v0 = *(LAS f32x4*)(st + (it * 8 + rsub) * 68 + c8), v1 = *(LAS f32x4*)(st + (it * 8 + rsub) * 68 + c8 + 4);
                    const u32x4 zw = *(const u32x4*)(A.z + gbase + (size_t)it * 8 * 512);
                    const f32x4 z0 = {bf_lo(zw.x), bf_hi(zw.x), bf_lo(zw.y), bf_hi(zw.y)}, z1 = {bf_lo(zw.z), bf_hi(zw.z), bf_lo(zw.w), bf_hi(zw.w)};
                    *(u32x4*)(A.y + gbase + (size_t)it * 8 * 512) = pack8(v0 * z0, v1 * z1);
                }
            }
        } else if (ATT_TEST & 2) {
            const int tid = wv * 64 + lane_now();
            const int bhd = (code - 2048u) >> 5, b = bhd >> 2, hd = bhd & 3;
            const size_t s0 = (size_t)(b * 8 + hd * 2) * SEQ * 64, s1 = s0 + (size_t)SEQ * 64;
            float* pk = A.park + (size_t)blockIdx.x * 32768 + tid * 64;
            f32x16 o[2][2];
            attn_pass<2, false>(L, A.qkv + 3 * SB + s0, A.qkv + 4 * SB + s0, A.qkv + 5 * SB + s0, A.qkv + 5 * SB + s1, nullptr, qb, o, tid, nullptr, -1.0f);
            { float* pk1 = pk; asm volatile("" : "+v"(pk1));
#pragma unroll
            for (int nv = 0; nv < 2; ++nv)
#pragma unroll
                for (int d0 = 0; d0 < 2; ++d0)
#pragma unroll
                    for (int j = 0; j < 4; ++j) { const f32x4 w = {o[nv][d0][4 * j], o[nv][d0][4 * j + 1], o[nv][d0][4 * j + 2], o[nv][d0][4 * j + 3]}; *(f32x4*)(pk1 + (nv * 2 + d0) * 16 + 4 * j) = w; }
            asm volatile("" ::: "memory"); }
            const int tid2_ = wv * 64 + lane_now();
            attn_pass<2, false>(L, A.qkv + 3 * SB + s1, A.qkv + 4 * SB + s1, A.qkv + 5 * SB + s0, A.qkv + 5 * SB + s1, nullptr, qb, o, tid2_, nullptr, -1.0f);
            f32x16 ss = f32x16{};
            const int lane2 = lane_now(), r32e = lane2 & 31, hie = lane2 >> 5;
            const float* pk2 = pk; asm volatile("" : "+v"(pk2));
#pragma unroll
            for (int nv = 0; nv < 2; ++nv)
#pragma unroll
                for (int d0 = 0; d0 < 2; ++d0) {
#pragma unroll
                    for (int j = 0; j < 4; ++j) { const f32x4 w = *(const f32x4*)(pk2 + (nv * 2 + d0) * 16 + 4 * j);
#pragma unroll
                        for (int i = 0; i < 4; ++i) { const int r = 4 * j + i; const float v = w[i] - A.lam * o[nv][d0][r]; o[nv][d0][r] = v; ss[r] += v * v; } }
                    asm volatile("" ::: "memory");
                }
#pragma unroll
            for (int r = 0; r < 16; ++r) { float s = ss[r]; s += xlane(s, lane2 ^ 1); s += xlane(s, lane2 ^ 2); s += xlane(s, lane2 ^ 4); s += xlane(s, lane2 ^ 8); s += xlane(s, lane2 ^ 16);
                ss[r] = 0.8f * __builtin_amdgcn_rsqf(s * (1.0f / 128.0f) + 1e-5f); }
            {
                LAS float* st = (LAS float*)(L + A_STAGE + wid * 8704);
                const int rsub = lane2 >> 3, c8 = (lane2 & 7) * 8;
                size_t gbase = (size_t)M * 512 + (size_t)(b * SEQ + q0w + rsub) * 512 + hd * 128 + c8; asm volatile("" : "+v"(gbase));
#pragma unroll
                for (int nv = 0; nv < 2; ++nv) {
#pragma unroll
                    for (int d0 = 0; d0 < 2; ++d0)
#pragma unroll
                        for (int r = 0; r < 16; ++r) st[((r & 3) + 8 * (r >> 2) + 4 * hie) * 68 + 32 * d0 + r32e] = o[nv][d0][r] * ss[r];
                    const f32x4 g0 = *(const f32x4*)(A.gsub + 64 * nv + c8), g1 = *(const f32x4*)(A.gsub + 64 * nv + c8 + 4);
#pragma unroll
                    for (int it = 0; it < 4; ++it) {
                        const f32x4 v0 = *(LAS f32x4*)(st + (it * 8 + rsub) * 68 + c8), v1 = *(LAS f32x4*)(st + (it * 8 + rsub) * 68 + c8 + 4);
                        const size_t gi = gbase + (size_t)it * 8 * 512 + 64 * nv;
                        const u32x4 zw = *(const u32x4*)(A.z + gi);
                        const f32x4 z0 = {bf_lo(zw.x), bf_hi(zw.x), bf_lo(zw.y), bf_hi(zw.y)}, z1 = {bf_lo(zw.z), bf_hi(zw.z), bf_lo(zw.w), bf_hi(zw.w)};
                        *(u32x4*)(A.y + gi) = pack8(v0 * g0 * z0, v1 * g1 * z1);
                    }
                    asm volatile("" ::: "memory");
                }
            }
        }
    }
    }
}

__device__ __forceinline__ int col_src(int n) {
    if (n >= 4096) return 4104 + (n - 4096);
    const int seg = n >> 9, c = n & 511;
    if (seg == 4 || seg == 5) { const int uu = c >> 6, p = c & 63, a = p >> 3, bb = p & 7; const int dim = bb < 4 ? 4 * a + bb : 32 + 4 * a + (bb - 4); return (seg == 4 ? 2056 : 2568) + uu * 64 + dim; }
    const int base = seg == 0 ? 0 : seg == 1 ? 512 : seg == 2 ? 1024 : seg == 3 ? 1544 : seg == 6 ? 3080 : 3592;
    return base + c;
}
template <bool MAP>
__device__ __forceinline__ void transpose_tile(LAS unsigned char* L, const float* __restrict__ src, int ld, int K, bf16_t* __restrict__ dst, int n0, int k0) {
    LAS float* ts = (LAS float*)L;
    const int tid = threadIdx.x, a = tid >> 6, c = tid & 63;
    const int sc = MAP ? col_src(n0 + c) : (n0 + c);
    float v[8];
#pragma unroll
    for (int p = 0; p < 8; ++p) v[p] = src[(size_t)(k0 + p * 8 + a) * ld + sc];
    __syncthreads();
#pragma unroll
    for (int p = 0; p < 8; ++p) ts[(p * 8 + a) * 65 + c] = v[p];
    __syncthreads();
#pragma unroll
    for (int p = 0; p < 8; ++p) { const int n = p * 8 + a; dst[(size_t)(n0 + n) * K + k0 + c] = bf16_1(ts[c * 65 + n]); }
}

struct P { const float* x; const float* g_pre; const float* w_in; const float* b_forget; const float* lq1; const float* lk1; const float* lq2; const float* lk2;
           const float* g_subln; const float* w_branch; const float* w_out; const float* g_post; float* out; unsigned char* ws; };

__device__ __forceinline__ void p0_prologue(LAS unsigned char* L, const P& p) {
    const int tid = threadIdx.x, lane = tid & 63, wid = tid >> 6;
    const int gtid = blockIdx.x * 512 + tid, gsz = gridDim.x * 512;
    unsigned char* ws = p.ws;
    float* ssq = (float*)(ws + WS_SSQ);
    for (int i = gtid; i < M; i += gsz) ssq[i] = 0.f;
    { float* kn2 = (float*)(ws + WS_KN2); for (int i = gtid; i < 64 * SEQ; i += gsz) kn2[i] = 0.f; }
    if (gtid < 8) ((unsigned*)(ws + WS_CTL))[32 * gtid] = 0u;
    if (gtid == 0) {
        float d1 = 0.f, d2 = 0.f;
        for (int i = 0; i < 64; ++i) { d1 += p.lq1[i] * p.lk1[i]; d2 += p.lq2[i] * p.lk2[i]; }
        ((float*)(ws + WS_CTL))[512] = expf(d1) - expf(d2) + 0.2f; }
    if (gtid < NITEMS) {
        unsigned* items = (unsigned*)(ws + WS_ITEMS); int rank; unsigned code;
        if (gtid < 1024) { const int qb = gtid >> 5, j = gtid & 31, c = 3 * (qb + 1); rank = 32 * (31 - qb) + 64 * (32 - c > 0 ? 32 - c : 0) + j; code = 2048u + (unsigned)(j * 32 + qb); }
        else { const int i2 = gtid - 1024, qb = i2 >> 6, j = i2 & 63, c = qb + 1; rank = 32 * (33 - (c + 2) / 3) + 64 * (32 - c) + j; code = (unsigned)(j * 32 + qb); }
        items[rank] = code;
    }
    {
        float* cs = (float*)(ws + WS_COS); float* sn = (float*)(ws + WS_SIN);
        for (int i = gtid; i < SEQ * 32; i += gsz) { const int s = i >> 5, f = i & 31;
            const double invf = exp2(-(double)f * (13.287712379549449 / 32.0));
            double rev = (double)s * invf * 0.15915494309189535; rev -= floor(rev);
            const float rf = (float)rev; cs[i] = __builtin_amdgcn_cosf(rf); sn[i] = __builtin_amdgcn_sinf(rf); }
    }
    for (int tt = blockIdx.x; tt < 2048; tt += gridDim.x) {
        if (tt < 1536) transpose_tile<true>(L, p.w_in, NIN, DM, (bf16_t*)(ws + WS_BT1), (tt >> 4) << 6, (tt & 15) << 6);
        else if (tt < 1792) { const int u = tt - 1536, br = u >> 7, v = u & 127;
            transpose_tile<false>(L, p.w_branch + (size_t)br * 512 * DM, DM, 512, (bf16_t*)(ws + WS_BT3A) + (size_t)br * DM * 512, (v >> 3) << 6, (v & 7) << 6); }
        else { const int u = tt - 1792; transpose_tile<false>(L, p.w_out, DM, DM, (bf16_t*)(ws + WS_BT3B), (u >> 4) << 6, (u & 15) << 6); }
    }
    {
        f32x4 gp[4]; float wf[4][4][8];
#pragma unroll
        for (int j = 0; j < 4; ++j) { gp[j] = *(const f32x4*)(p.g_pre + 4 * lane + 256 * j);
#pragma unroll
            for (int i = 0; i < 4; ++i) { const float* wp = p.w_in + (size_t)(4 * lane + 256 * j + i) * NIN + 1536; const f32x4 w0 = *(const f32x4*)wp, w1 = *(const f32x4*)(wp + 4);
                wf[j][i][0] = w0[0]; wf[j][i][1] = w0[1]; wf[j][i][2] = w0[2]; wf[j][i][3] = w0[3]; wf[j][i][4] = w1[0]; wf[j][i][5] = w1[1]; wf[j][i][6] = w1[2]; wf[j][i][7] = w1[3]; } }
        const int hh = (lane & 1) * 4 + ((lane >> 1) & 1) * 2 + ((lane >> 2) & 1);
        const float bfg = p.b_forget[hh];
        bf16_t* hb = (bf16_t*)(ws + WS_H); float* logf_ = (float*)(ws + WS_LOGF);
        const int rstep = gridDim.x * 8;
        int row = blockIdx.x * 8 + wid;
        f32x4 xv[4], xm[4], xn[4];
#pragma unroll
        for (int j = 0; j < 4; ++j) xv[j] = __builtin_nontemporal_load((const f32x4*)(p.x + (size_t)row * DM + 4 * lane + 256 * j));
        { const int r1 = row + rstep < M ? row + rstep : row;
#pragma unroll
          for (int j = 0; j < 4; ++j) xm[j] = __builtin_nontemporal_load((const f32x4*)(p.x + (size_t)r1 * DM + 4 * lane + 256 * j)); }
        for (; row < M; row += rstep) {
            const int rnext = row + 2 * rstep < M ? row + 2 * rstep : row;
#pragma unroll
            for (int j = 0; j < 4; ++j) xn[j] = __builtin_nontemporal_load((const f32x4*)(p.x + (size_t)rnext * DM + 4 * lane + 256 * j));
            float ss = 0.f;
#pragma unroll
            for (int j = 0; j < 4; ++j) ss += (xv[j][0] * xv[j][0] + xv[j][1] * xv[j][1]) + (xv[j][2] * xv[j][2] + xv[j][3] * xv[j][3]);
#pragma unroll
            for (int o = 1; o < 64; o <<= 1) ss += __shfl_xor(ss, o);
            const float rs = 1.0f / sqrtf(ss * (1.0f / 1024.0f) + 1e-6f);
            float fa[8] = {0.f, 0.f, 0.f, 0.f, 0.f, 0.f, 0.f, 0.f};
#pragma unroll
            for (int j = 0; j < 4; ++j) { const f32x4 hv = xv[j] * rs * gp[j];
                u32x2 w; w.x = pk_bf16(hv[0], hv[1]); w.y = pk_bf16(hv[2], hv[3]); *(u32x2*)(hb + (size_t)row * DM + 4 * lane + 256 * j) = w;
#pragma unroll
                for (int i = 0; i < 4; ++i)
#pragma unroll
                    for (int e = 0; e < 8; ++e) fa[e] += hv[i] * wf[j][i][e]; }
            float g4[4], g2[2], g1;
            { const bool up = (lane & 1) != 0;
#pragma unroll
              for (int k = 0; k < 4; ++k) { const float snd = up ? fa[k] : fa[k + 4]; const float rcv = __shfl_xor(snd, 1); g4[k] = (up ? fa[k + 4] : fa[k]) + rcv; } }
            { const bool up = (lane & 2) != 0;
#pragma unroll
              for (int k = 0; k < 2; ++k) { const float snd = up ? g4[k] : g4[k + 2]; const float rcv = __shfl_xor(snd, 2); g2[k] = (up ? g4[k + 2] : g4[k]) + rcv; } }
            { const bool up = (lane & 4) != 0; const float snd = up ? g2[0] : g2[1]; const float rcv = __shfl_xor(snd, 4); g1 = (up ? g2[1] : g2[0]) + rcv; }
            g1 += __shfl_xor(g1, 8); g1 += __shfl_xor(g1, 16); g1 += __shfl_xor(g1, 32);
            if (lane < 8) { const float zf = g1 + bfg; const float ls = fminf(zf, 0.f) - log1pf(expf(-fabsf(zf)));
                logf_[(size_t)((row >> 13) * 8 + hh) * SEQ + (row & (SEQ - 1))] = ls; }
#pragma unroll
            for (int j = 0; j < 4; ++j) { xv[j] = xm[j]; xm[j] = xn[j]; }
        }
    }
}

__device__ __forceinline__ void cumsum_part(LAS unsigned char* L, const float* __restrict__ lf, float* __restrict__ cb, const int q, const int wv) {
    const int lane = lane_now(), wid = wv, tid = wv * 64 + lane;
    LAS float* wt = (LAS float*)L;
    float part = 0.f;
    for (int i = tid; i < 2048 * q; i += 512) part += lf[i];
    f32x4 v = *(const f32x4*)(lf + 2048 * q + tid * 4); float run = 0.f;
#pragma unroll
    for (int i = 0; i < 4; ++i) { run += v[i]; v[i] = run; }
    float sc = run;
#pragma unroll
    for (int o = 1; o < 64; o <<= 1) { const float n = __shfl_up(sc, o); if (lane >= o) sc += n; }
#pragma unroll
    for (int o = 1; o < 64; o <<= 1) part += __shfl_xor(part, o);
    __syncthreads();
    if (lane == 63) wt[wid] = sc;
    if (lane == 0) wt[8 + wid] = part;
    __syncthreads();
    float pre = sc - run;
    for (int w = 0; w < wid; ++w) pre += wt[w];
#pragma unroll
    for (int w = 0; w < 8; ++w) pre += wt[8 + w];
    f32x4 r;
#pragma unroll
    for (int i = 0; i < 4; ++i) r[i] = -(pre + v[i]) * LOG2E;
    *(f32x4*)(cb + 2048 * q + tid * 4) = r;
    __syncthreads();
}

__global__ void __launch_bounds__(512) fwd_megakernel(P p) {
    extern __shared__ __attribute__((aligned(16))) unsigned char lds_raw[];
    LAS unsigned char* L = (LAS unsigned char*)lds_raw;
    cg::grid_group grid = cg::this_grid();
    unsigned char* ws = p.ws;
    const int G = gridDim.x, c = blockIdx.x;
    const int wv = __builtin_amdgcn_readfirstlane(threadIdx.x >> 6);
    bf16_t* qkv = (bf16_t*)(ws + WS_QKV); bf16_t* zbuf = (bf16_t*)(ws + WS_Z); bf16_t* gbuf = (bf16_t*)(ws + WS_G);

#ifndef PHM
#define PHM 63
#endif
    if (PHM & 1) p0_prologue(L, p);
    grid.sync();

    if (PHM & 2) for (int job = c; job < 256; job += G) cumsum_part(L, (const float*)(ws + WS_LOGF) + (size_t)(job >> 2) * SEQ, (float*)(ws + WS_CB) + (size_t)(job >> 2) * SEQ, job & 3, wv);
    if (PHM & 2) {
        pg8::Gemm g{(const bf16_t*)(ws + WS_H), (const bf16_t*)(ws + WS_BT1), M, N1, DM}; pg8::StaticOrder S; S.init(M, N1, G, c);
        Epi1 E{qkv, zbuf, gbuf, (const float*)(ws + WS_COS), (const float*)(ws + WS_SIN), (float*)(ws + WS_KN2)};
        pg8::gemm_phase<Epi1, pg8::StaticOrder, true, true>(L, g, S, E, wv);
    }
    grid.sync();

    if (PHM & 4) {
        const float lam = ((const float*)(ws + WS_CTL))[512];
        AttnArgs A{qkv, (const float*)(ws + WS_CB), zbuf, (bf16_t*)(ws + WS_Y), (float*)(ws + WS_PARK), (const float*)(ws + WS_KN2), (unsigned*)(ws + WS_CTL), p.g_subln, lam};
        attn_phase(L, A, wv);
    }
    grid.sync();

    if (PHM & 8) {
        pg8::Gemm g{(const bf16_t*)(ws + WS_Y), (const bf16_t*)(ws + WS_BT3A), 2 * M, 2 * DM, 512}; Sched3a S; S.so.init(M, DM, G, c);
        Epi3a E{gbuf, (bf16_t*)(ws + WS_T), (bf16_t*)(ws + WS_MERGED)};
        pg8::gemm_phase<Epi3a, Sched3a, true, true>(L, g, S, E, wv);
    }
    grid.sync();

    if (PHM & 16) {
        pg8::Gemm g{(const bf16_t*)(ws + WS_MERGED), (const bf16_t*)(ws + WS_BT3B), M, DM, DM}; pg8::StaticOrder S; S.init(M, DM, G, c);
        Epi3b E{(bf16_t*)(ws + WS_Z), (float*)(ws + WS_SSQ)};
        pg8::gemm_phase<Epi3b, pg8::StaticOrder, true, true>(L, g, S, E, wv);
    }
    grid.sync();

    if (PHM & 32) {
        const float* ssq = (const float*)(ws + WS_SSQ);
        const int t4_ = wv * 64 + lane_now();
        const int gtid = c * 512 + t4_, gsz = G * 512;
        for (int i = gtid; i < M * 256; i += gsz) {
            const int row = i >> 8, c4 = i & 255;
            const u32x2 yw = *(const u32x2*)((const bf16_t*)(ws + WS_Z) + (size_t)i * 4); const f32x4 yv = {bf_lo(yw.x), bf_hi(yw.x), bf_lo(yw.y), bf_hi(yw.y)};
            const f32x4 xv = *(const f32x4*)(p.x + (size_t)i * 4), gv = *(const f32x4*)(p.g_post + c4 * 4);
            const float rs = 1.0f / sqrtf(ssq[row] * (1.0f / 1024.0f) + 1e-6f);
            *(f32x4*)(p.out + (size_t)i * 4) = xv + yv * rs * gv;
        }
    }
}
}

extern "C" void kernel_launch(void* const* d_in, const int* in_sizes, int n_in, void* d_out, int out_size, void* d_ws, size_t ws_size, hipStream_t stream) {
    static int grid = 0;
    if (grid == 0) {
        if (n_in != 12 || ws_size < mk::WS_END) { fprintf(stderr, "kernel_launch: unexpected n_in %d / ws_size %zu\n", n_in, ws_size); grid = -1; return; }
        int dev = 0, cus = 0, per_cu = 0;
        hipGetDevice(&dev); hipDeviceGetAttribute(&cus, hipDeviceAttributeMultiprocessorCount, dev);
        if (hipFuncSetAttribute((const void*)mk::fwd_megakernel, hipFuncAttributeMaxDynamicSharedMemorySize, mk::LDS_BYTES) != hipSuccess) { fprintf(stderr, "kernel_launch: hipFuncSetAttribute failed\n"); grid = -1; return; }
        if (hipOccupancyMaxActiveBlocksPerMultiprocessor(&per_cu, (const void*)mk::fwd_megakernel, 512, mk::LDS_BYTES) != hipSuccess || per_cu < 1) { fprintf(stderr, "kernel_launch: occupancy query says %d\n", per_cu); per_cu = 1; }
        (void)hipGetLastError();
        grid = cus;
    }
    if (grid < 0) return;
    mk::P p{};
    p.x = (const float*)d_in[0]; p.g_pre = (const float*)d_in[1]; p.w_in = (const float*)d_in[2]; p.b_forget = (const float*)d_in[3];
    p.lq1 = (const float*)d_in[4]; p.lk1 = (const float*)d_in[5]; p.lq2 = (const float*)d_in[6]; p.lk2 = (const float*)d_in[7];
    p.g_subln = (const float*)d_in[8]; p.w_branch = (const float*)d_in[9]; p.w_out = (const float*)d_in[10]; p.g_post = (const float*)d_in[11];
    p.out = (float*)d_out; p.ws = (unsigned char*)d_ws;
    void* args[] = {&p};
    hipError_t e = hipLaunchCooperativeKernel((const void*)mk::fwd_megakernel, dim3(grid), dim3(512), args, mk::LDS_BYTES, stream);
    if (e != hipSuccess) fprintf(stderr, "cooperative launch failed: %s (grid %d)\n", hipGetErrorString(e), grid);
}
```
